# Optimizing an MI355X kernel written in HIP

```python
import numpy as np
import jax
import jax.numpy as jnp
from jax import lax


D_MODEL = 1024
BATCH = 8
SEQ = 2048
DEPTH = 2

N_MIXERS = 4
GROUP_WIDTH = D_MODEL // N_MIXERS
D_MIX = N_MIXERS * GROUP_WIDTH
CONV_WIDTH = 31
POOL_WINDOWS = (2, 4, 8, 16)
POOL_GROUP = GROUP_WIDTH // len(POOL_WINDOWS)
SGU_HEADS = 4
SGU_HEAD_DIM = GROUP_WIDTH // SGU_HEADS
SGU_CHUNK = 128
ATT_HEADS = 4
HEAD_DIM = GROUP_WIDTH // ATT_HEADS
KV_DIM = HEAD_DIM
ROPE_DIM = HEAD_DIM // 4
ROPE_THETA = 500000.0
CMP_BLOCK = 32
CMP_STRIDE = 16
SLC_BLOCK = 64
N_SELECT = 8
N_LOCAL = 2
WINDOW = 512
Q_BLOCK = 128
N_BRANCH = 3
D_FF = 4 * D_MODEL
NORM_EPS = 1e-6
NEG_INF = -1e30
FORCE_SCORE = 1e9
IN_WIDTHS = (GROUP_WIDTH, GROUP_WIDTH, GROUP_WIDTH, GROUP_WIDTH, GROUP_WIDTH, ATT_HEADS * HEAD_DIM, KV_DIM, KV_DIM, KV_DIM, KV_DIM, KV_DIM, KV_DIM, ATT_HEADS * N_BRANCH)
D_IN = 5 * GROUP_WIDTH + ATT_HEADS * HEAD_DIM + 6 * KV_DIM + ATT_HEADS * N_BRANCH

kernel_name = 'hybrid_parallel_group_block'


def rms_norm(x, g):
    xf = x.astype(jnp.float32)
    y = xf * lax.rsqrt(jnp.mean(xf * xf, axis=-1, keepdims=True) + NORM_EPS)
    return (y * g.astype(jnp.float32)).astype(x.dtype)


def layer_norm(x, g, b):
    xf = x.astype(jnp.float32)
    mu = jnp.mean(xf, axis=-1, keepdims=True)
    var = jnp.mean(jnp.square(xf - mu), axis=-1, keepdims=True)
    y = (xf - mu) * lax.rsqrt(var + NORM_EPS)
    return (y * g.astype(jnp.float32) + b.astype(jnp.float32)).astype(x.dtype)


def rope(x, pos):
    half = ROPE_DIM // 2
    inv = ROPE_THETA ** (-jnp.arange(half, dtype=jnp.float32) * 2.0 / ROPE_DIM)
    ang = pos.astype(jnp.float32)[..., None] * inv
    cos = jnp.cos(ang)[:, :, None, :]
    sin = jnp.sin(ang)[:, :, None, :]
    xf = x.astype(jnp.float32)
    x1 = xf[..., :half]
    x2 = xf[..., half:ROPE_DIM]
    out = jnp.concatenate([x1 * cos - x2 * sin, x2 * cos + x1 * sin, xf[..., ROPE_DIM:]], axis=-1)
    return out.astype(x.dtype)


def conv_group(a, gate, w, b, ln_g, ln_b):
    h = a * jax.nn.sigmoid(gate)
    c = h.shape[-1]
    h = lax.conv_general_dilated(h, w[:, None, :], window_strides=(1,), padding=[(CONV_WIDTH - 1, 0)], dimension_numbers=('NWC', 'WIO', 'NWC'), feature_group_count=c) + b
    return jax.nn.silu(layer_norm(h, ln_g, ln_b))


def pool_group(p, w, scale):
    bsz, s, c = p.shape
    cs = jnp.pad(jnp.cumsum(p.astype(jnp.float32), axis=1), ((0, 0), (1, 0), (0, 0)))
    t = jnp.arange(s)
    outs = []
    for gi, win in enumerate(POOL_WINDOWS):
        sl = slice(gi * POOL_GROUP, (gi + 1) * POOL_GROUP)
        lo = jnp.maximum(t + 1 - win, 0)
        total = cs[:, 1:, sl] - cs[:, lo, sl]
        count = (t + 1 - lo).astype(jnp.float32)[None, :, None]
        mixed = (total / count - p[..., sl].astype(jnp.float32)).astype(p.dtype)
        outs.append(jnp.einsum('bsc,cd->bsd', mixed, w[gi]))
    return jnp.concatenate(outs, axis=-1) * scale


def sgu_group(u, v, ln_g, ln_b, w_s, b_s):
    bsz, s, c = u.shape
    u = jax.nn.gelu(u)
    v = layer_norm(jax.nn.gelu(v), ln_g, ln_b)
    nc = s // SGU_CHUNK
    v = v.reshape(bsz, nc, SGU_CHUNK, SGU_HEADS, SGU_HEAD_DIM)
    mask = jnp.tril(jnp.ones((SGU_CHUNK, SGU_CHUNK), dtype=bool))
    w = jnp.where(mask[None], w_s, 0)
    mixed = jnp.einsum('hts,bcshd->bcthd', w, v) + jnp.transpose(b_s)[None, None, :, :, None]
    return u * mixed.reshape(bsz, s, c)


def nsa_group(q, kc, vc, ks, vs, kw, vw, gates, positions, pe_k, w1_k, w2_k, pe_v, w1_v, w2_v):
    bsz, s, _ = q.shape
    scale = HEAD_DIM ** -0.5
    t = jnp.arange(s)
    q = rope(q.reshape(bsz, s, ATT_HEADS, HEAD_DIM), positions)

    n_cmp = (s - CMP_BLOCK) // CMP_STRIDE + 1
    blk_start = jnp.arange(n_cmp) * CMP_STRIDE
    blk_end = blk_start + CMP_BLOCK - 1
    blk_idx = blk_start[:, None] + jnp.arange(CMP_BLOCK)[None, :]

    def compress(xx, pe, w1, w2):
        xb = xx[:, blk_idx] + pe
        hid = jax.nn.gelu(jnp.einsum('bnf,fd->bnd', xb.reshape(bsz, n_cmp, CMP_BLOCK * KV_DIM), w1))
        return jnp.einsum('bnd,de->bne', hid, w2)

    k_cmp = compress(kc, pe_k, w1_k, w2_k)
    v_cmp = compress(vc, pe_v, w1_v, w2_v)
    k_cmp = rope(k_cmp[:, :, None], positions[:, blk_end])[:, :, 0]
    s_cmp = jnp.einsum('bthd,bnd->bhtn', q, k_cmp).astype(jnp.float32) * scale
    cmp_mask = blk_end[None, :] <= t[:, None]
    p_cmp = jax.nn.softmax(jnp.where(cmp_mask, s_cmp, NEG_INF), axis=-1) * cmp_mask
    o_cmp = jnp.einsum('bhtn,bnd->bthd', p_cmp.astype(v_cmp.dtype), v_cmp)

    n_slc = s // SLC_BLOCK
    k_sel = min(N_SELECT, n_slc)
    slc_start = jnp.arange(n_slc) * SLC_BLOCK
    overlap = jnp.clip(jnp.minimum(blk_start[:, None] + CMP_BLOCK, slc_start[None, :] + SLC_BLOCK) - jnp.maximum(blk_start[:, None], slc_start[None, :]), 0).astype(jnp.float32) / CMP_STRIDE
    imp = jnp.einsum('bhtn,nj->btj', p_cmp, overlap)
    q_blk = t // SLC_BLOCK
    j = jnp.arange(n_slc)
    back = q_blk[:, None] - j[None, :]
    forced = (j[None, :] == 0) | ((back >= 0) & (back < N_LOCAL))
    imp = jnp.where(forced, FORCE_SCORE, jnp.where(back < 0, -1.0, imp))
    _, sel = lax.top_k(imp, k_sel)

    k_blocks = rope(ks[:, :, None], positions)[:, :, 0].reshape(bsz, n_slc, SLC_BLOCK, KV_DIM)
    v_blocks = vs.reshape(bsz, n_slc, SLC_BLOCK, KV_DIM)
    nq = s // Q_BLOCK

    def slc_chunk(args):
        qc, sc, tc = args
        kg = jax.vmap(lambda kb, ix: kb[ix])(k_blocks, sc)
        vg = jax.vmap(lambda vb, ix: vb[ix])(v_blocks, sc)
        sco = jnp.einsum('bqhd,bqkld->bhqkl', qc, kg).astype(jnp.float32) * scale
        kpos = sc[..., None] * SLC_BLOCK + jnp.arange(SLC_BLOCK)
        mask = (kpos <= tc[None, :, None, None])[:, None]
        sco = jnp.where(mask, sco, NEG_INF).reshape(bsz, ATT_HEADS, Q_BLOCK, k_sel * SLC_BLOCK)
        p = jax.nn.softmax(sco, axis=-1).reshape(bsz, ATT_HEADS, Q_BLOCK, k_sel, SLC_BLOCK)
        return jnp.einsum('bhqkl,bqkld->bqhd', p.astype(vg.dtype), vg)

    q_chunks = jnp.transpose(q.reshape(bsz, nq, Q_BLOCK, ATT_HEADS, HEAD_DIM), (1, 0, 2, 3, 4))
    sel_chunks = jnp.transpose(sel.reshape(bsz, nq, Q_BLOCK, k_sel), (1, 0, 2, 3))
    o_slc = lax.map(slc_chunk, (q_chunks, sel_chunks, t.reshape(nq, Q_BLOCK)))
    o_slc = jnp.transpose(o_slc, (1, 0, 2, 3, 4)).reshape(bsz, s, ATT_HEADS, HEAD_DIM)

    kw_r = rope(kw[:, :, None], positions)[:, :, 0]
    pad = ((0, 0), (WINDOW, 0), (0, 0))
    kw_p = jnp.pad(kw_r, pad)
    vw_p = jnp.pad(vw, pad)
    span = WINDOW + Q_BLOCK
    band = jnp.arange(nq)[:, None] * Q_BLOCK + jnp.arange(span)[None, :]
    kb = kw_p[:, band]
    vb = vw_p[:, band]
    qb = q.reshape(bsz, nq, Q_BLOCK, ATT_HEADS, HEAD_DIM)
    sco = jnp.einsum('bcqhd,bckd->bhcqk', qb, kb).astype(jnp.float32) * scale
    kpos = band - WINDOW
    diff = t.reshape(nq, Q_BLOCK)[:, :, None] - kpos[:, None, :]
    wmask = (kpos[:, None, :] >= 0) & (diff >= 0) & (diff < WINDOW)
    p = jax.nn.softmax(jnp.where(wmask, sco, NEG_INF), axis=-1)
    o_win = jnp.einsum('bhcqk,bckd->bcqhd', p.astype(vb.dtype), vb).reshape(bsz, s, ATT_HEADS, HEAD_DIM)

    g = jax.nn.sigmoid(gates.reshape(bsz, s, ATT_HEADS, N_BRANCH))
    o = g[..., 0:1] * o_cmp + g[..., 1:2] * o_slc + g[..., 2:3] * o_win
    return o.reshape(bsz, s, ATT_HEADS * HEAD_DIM)


def setup_inputs(seed: int = 0) -> dict:
    key = jax.random.key(seed)
    keys = iter(jax.random.split(key, 32))
    f32 = jnp.float32
    L = DEPTH

    def nrm(shape, scale):
        return jax.random.normal(next(keys), shape, f32) * scale

    def gain(shape):
        return 1.0 + nrm(shape, 0.05)

    x = jax.random.normal(next(keys), (BATCH, SEQ, D_MODEL), f32)
    positions = jnp.arange(SEQ, dtype=jnp.int32)[None, :] + jax.random.randint(next(keys), (BATCH, 1), 0, 4096, dtype=jnp.int32)
    return {
        'x': x,
        'positions': positions,
        'pre_mix_norm': gain((L, D_MODEL)),
        'post_mix_norm': gain((L, D_MODEL)),
        'pre_ffn_norm': gain((L, D_MODEL)),
        'post_ffn_norm': gain((L, D_MODEL)),
        'w_in': nrm((L, D_MODEL, D_IN), D_MODEL ** -0.5),
        'conv_w': nrm((L, CONV_WIDTH, GROUP_WIDTH), CONV_WIDTH ** -0.5),
        'conv_b': nrm((L, GROUP_WIDTH), 0.02),
        'conv_ln_g': gain((L, GROUP_WIDTH)),
        'conv_ln_b': nrm((L, GROUP_WIDTH), 0.02),
        'pool_w': nrm((L, len(POOL_WINDOWS), POOL_GROUP, POOL_GROUP), POOL_GROUP ** -0.5),
        'pool_scale': 1.0 + nrm((L, GROUP_WIDTH), 0.1),
        'sgu_ln_g': gain((L, GROUP_WIDTH)),
        'sgu_ln_b': nrm((L, GROUP_WIDTH), 0.02),
        'sgu_w': nrm((L, SGU_HEADS, SGU_CHUNK, SGU_CHUNK), SGU_CHUNK ** -0.5),
        'sgu_b': 1.0 + nrm((L, SGU_HEADS, SGU_CHUNK), 0.05),
        'cmp_k_pe': nrm((L, CMP_BLOCK, KV_DIM), 0.1),
        'cmp_k_w1': nrm((L, CMP_BLOCK * KV_DIM, KV_DIM), (CMP_BLOCK * KV_DIM) ** -0.5),
        'cmp_k_w2': nrm((L, KV_DIM, KV_DIM), KV_DIM ** -0.5),
        'cmp_v_pe': nrm((L, CMP_BLOCK, KV_DIM), 0.1),
        'cmp_v_w1': nrm((L, CMP_BLOCK * KV_DIM, KV_DIM), (CMP_BLOCK * KV_DIM) ** -0.5),
        'cmp_v_w2': nrm((L, KV_DIM, KV_DIM), KV_DIM ** -0.5),
        'w_out': nrm((L, D_MIX, D_MODEL), D_MIX ** -0.5),
        'ffn_w1': nrm((L, D_MODEL, D_FF), D_MODEL ** -0.5),
        'ffn_w2': nrm((L, D_FF, D_MODEL), D_FF ** -0.5),
    }


def reference(x, positions, pre_mix_norm, post_mix_norm, pre_ffn_norm, post_ffn_norm, w_in, conv_w, conv_b, conv_ln_g, conv_ln_b, pool_w, pool_scale, sgu_ln_g, sgu_ln_b, sgu_w, sgu_b, cmp_k_pe, cmp_k_w1, cmp_k_w2, cmp_v_pe, cmp_v_w1, cmp_v_w2, w_out, ffn_w1, ffn_w2):
    splits = np.cumsum(IN_WIDTHS)[:-1].tolist()
    for l in range(DEPTH):
        h = rms_norm(x, pre_mix_norm[l])
        z = jnp.einsum('bsd,de->bse', h, w_in[l])
        (c_val, c_gate, p_in, s_u, s_v, q, kc, vc, ks, vs, kw, vw, g) = jnp.split(z, splits, axis=-1)
        y_conv = conv_group(c_val, c_gate, conv_w[l], conv_b[l], conv_ln_g[l], conv_ln_b[l])
        y_pool = pool_group(p_in, pool_w[l], pool_scale[l])
        y_sgu = sgu_group(s_u, s_v, sgu_ln_g[l], sgu_ln_b[l], sgu_w[l], sgu_b[l])
        y_nsa = nsa_group(q, kc, vc, ks, vs, kw, vw, g, positions, cmp_k_pe[l], cmp_k_w1[l], cmp_k_w2[l], cmp_v_pe[l], cmp_v_w1[l], cmp_v_w2[l])
        mix = jnp.concatenate([y_conv, y_pool, y_sgu, y_nsa], axis=-1)
        x = x + rms_norm(jnp.einsum('bse,ed->bsd', mix, w_out[l]), post_mix_norm[l])
        h = rms_norm(x, pre_ffn_norm[l])
        f = jnp.square(jax.nn.relu(jnp.einsum('bsd,df->bsf', h, ffn_w1[l])))
        x = x + rms_norm(jnp.einsum('bsf,fd->bsd', f, ffn_w2[l]), post_ffn_norm[l])
    return x
```

```cpp
#include <hip/hip_runtime.h>
#include <hip/hip_cooperative_groups.h>
#include <cstdio>
#include <cstdint>
namespace cg = cooperative_groups;
namespace pg8 {
#define PG8_LAS __attribute__((address_space(3)))
typedef unsigned short bf16_t;
typedef short bf16x8 __attribute__((ext_vector_type(8)));
typedef float f32x4 __attribute__((ext_vector_type(4)));
typedef unsigned u32x4 __attribute__((ext_vector_type(4)));
constexpr int BM = 256, BK = 64, HALF = 128, HTB = HALF * BK * 2  , STAGE_BYTES = 8 * HTB, NXCD = 8, WGM = 8;

__host__ __device__ __forceinline__ int lds_byte(int r, int c) { const int st = (r >> 4) * 2 + (c >> 5), rr = r & 15, cc = c & 31, ob = rr * 64 + cc * 2; return st * 1024 + (ob ^ (((ob >> 9) & 1) << 5)); }
__host__ __device__ __forceinline__ void stage_rc(int b, int& R, int& C) { const int st = b / 1024, sb = b % 1024, swz = sb ^ (((sb >> 9) & 1) << 5); R = (st >> 1) * 16 + swz / 64; C = (st & 1) * 32 + (swz % 64) / 2; }
__host__ __device__ __forceinline__ int perm32(int rho) { const int n = rho >> 4, i = rho & 15; return 8 * (i >> 2) + 4 * n + (i & 3); }

struct Unit { int pm, pn; };
struct Gemm { const bf16_t* A; const bf16_t* Bt; int M, N, K; };

struct StaticOrder {
    int nM, nN, nwg, G, c;
    __host__ __device__ void init(int M, int N, int G_, int c_) { nM = M / BM; nN = N / BM; nwg = nM * nN; G = G_; c = c_; }
    __host__ __device__ bool next(int i, Unit& u) const {
        const long L = (long)i * G + c; if (L >= nwg) return false;
        int wgid = (int)L; { const int q = nwg / NXCD, r = nwg % NXCD, xcd = wgid % NXCD, off = wgid / NXCD; wgid = (xcd < r ? xcd * (q + 1) : r * (q + 1) + (xcd - r) * q) + off; }
        const int nig = WGM * nN, gid = wgid / nig, fm = gid * WGM, gsz = (nM - fm) < WGM ? (nM - fm) : WGM;
        u.pm = fm + ((wgid % nig) % gsz); u.pn = (wgid % nig) / gsz; return true;
    }
    __device__ __forceinline__ void a_ready(const Unit&) const {}
    __device__ __forceinline__ void done(const Unit&) const {}
};

__device__ __forceinline__ unsigned cvt_pk_bf16(float lo, float hi) { unsigned r; asm volatile("v_cvt_pk_bf16_f32 %0, %1, %2" : "=v"(r) : "v"(lo), "v"(hi)); return r; }
typedef float f32x2 __attribute__((ext_vector_type(2)));
template <int ACT  > struct EpiBf16 {
    static constexpr bool PERM = true, AFTER_DRAIN = false;
    bf16_t* O; int ldc;
    __device__ __forceinline__ void operator()(const f32x4 (&acc)[2][2][4][2], const Unit& u, int wr, int wc, int fr, int fq) const {
        const int row0 = u.pm * BM + wr * 64 + fr; const int col0 = u.pn * BM + wc * 32 + 8 * fq;
#pragma unroll
        for (int ai = 0; ai < 2; ++ai)
#pragma unroll
            for (int m = 0; m < 4; ++m) { bf16_t* rowp = O + (size_t)(row0 + ai * HALF + m * 16) * ldc + col0;
#pragma unroll
                for (int bj = 0; bj < 2; ++bj) { f32x4 v0 = acc[ai][bj][m][0], v1 = acc[ai][bj][m][1];
                    if (ACT == 2) {
#pragma unroll
                        for (int j = 0; j < 4; ++j) { const float a = v0[j] > 0.f ? v0[j] : 0.f, b = v1[j] > 0.f ? v1[j] : 0.f; v0[j] = a * a; v1[j] = b * b; } }
                    u32x4 w; w.x = cvt_pk_bf16(v0[0], v0[1]); w.y = cvt_pk_bf16(v0[2], v0[3]); w.z = cvt_pk_bf16(v1[0], v1[1]); w.w = cvt_pk_bf16(v1[2], v1[3]);
                    *(u32x4*)(rowp + bj * HALF) = w; } }
    }
};
struct EpiF32 {
    static constexpr bool PERM = false, AFTER_DRAIN = false;
    float* O; int ldc;
    __device__ __forceinline__ void operator()(const f32x4 (&acc)[2][2][4][2], const Unit& u, int wr, int wc, int fr, int fq) const {
        const int row0 = u.pm * BM + wr * 64 + fr; const int col0 = u.pn * BM + wc * 32 + 4 * fq;
#pragma unroll
        for (int ai = 0; ai < 2; ++ai)
#pragma unroll
            for (int m = 0; m < 4; ++m) { float* rowp = O + (size_t)(row0 + ai * HALF + m * 16) * ldc + col0;
#pragma unroll
                for (int bj = 0; bj < 2; ++bj)
#pragma unroll
                    for (int n = 0; n < 2; ++n) *(f32x4*)(rowp + bj * HALF + n * 16) = acc[ai][bj][m][n]; }
    }
};
template <class Epi, class Sched, bool ALIGN_EPI = false, bool SP2 = false>
__device__ __forceinline__ void gemm_phase(PG8_LAS unsigned char* lds, const Gemm g, const Sched& S, const Epi& E) {
    int tid_ = threadIdx.x; asm volatile("" : "+v"(tid_)); const int tid = tid_, wid = __builtin_amdgcn_readfirstlane(tid >> 6), lane = tid & 63, wr = wid >> 2, wc = wid & 3, fr = lane & 15, fq = lane >> 4;
    const int K = g.K, nt = K / BK;
    unsigned voffA[2], voffB[2];
#pragma unroll
    for (int i = 0; i < 2; ++i) { int R, C; stage_rc(tid * 16 + i * 8192, R, C); const int Rb = Epi::PERM ? ((R & ~31) + perm32(R & 31)) : R;
        voffA[i] = (unsigned)(R * K + C) * 2u; voffB[i] = (unsigned)(Rb * K + C) * 2u; }
    const size_t kstep = (size_t)(BK * 2);
    const size_t hstep = (size_t)HALF * K * 2;
    const size_t tstep = 2 * hstep;
    const unsigned ldsw = (unsigned)wid * 1024u;
    const int aoff = lds_byte(wr * 64 + fr, fq * 8), boff = lds_byte(wc * 32 + fr, fq * 8);
#define PG8_SA(b, h) (((b) * 2 + (h)) * HTB)
#define PG8_SB(b, h) ((4 + (b) * 2 + (h)) * HTB)
#define PG8_STAGE(bufoff, gbase, voff) do { _Pragma("unroll") for (int _i = 0; _i < 2; ++_i) \
        __builtin_amdgcn_global_load_lds((const unsigned*)((const char*)(gbase) + (voff)[_i]), (PG8_LAS unsigned*)(lds + (bufoff) + ldsw + _i * 8192), 16, 0, 0); } while (0)
#define PG8_LDA(dst, b, h) do { _Pragma("unroll") for (int m = 0; m < 4; ++m) _Pragma("unroll") for (int k = 0; k < 2; ++k) dst[m][k] = *(const PG8_LAS bf16x8*)(lds + PG8_SA(b, h) + aoff + m * 2048 + k * 1024); } while (0)
#define PG8_LDB(dst, b, h) do { _Pragma("unroll") for (int n = 0; n < 2; ++n) _Pragma("unroll") for (int k = 0; k < 2; ++k) dst[n][k] = *(const PG8_LAS bf16x8*)(lds + PG8_SB(b, h) + boff + n * 2048 + k * 1024); } while (0)
#define PG8_MMA(ai, bj, At, Bt) do { __builtin_amdgcn_s_setprio(1); _Pragma("unroll") for (int m = 0; m < 4; ++m) _Pragma("unroll") for (int n = 0; n < 2; ++n) _Pragma("unroll") for (int k = 0; k < 2; ++k) \
        acc[ai][bj][m][n] = __builtin_amdgcn_mfma_f32_16x16x32_bf16(Bt[n][k], At[m][k], acc[ai][bj][m][n], 0, 0, 0); __builtin_amdgcn_s_setprio(0); } while (0)
#define PG8_WAIT_V(n) asm volatile("s_waitcnt vmcnt(" #n ")" ::: "memory")
#define PG8_WAIT_L(n) asm volatile("s_waitcnt lgkmcnt(" #n ")" ::: "memory")
#define PG8_BAR __builtin_amdgcn_s_barrier()
#define PG8_SCHED __builtin_amdgcn_sched_barrier(0)
    Unit cur, nxt; int ui = 0;
    if (!S.next(0, cur)) return;
    f32x4 acc[2][2][4][2];
#pragma unroll
    for (int a = 0; a < 2; ++a)
#pragma unroll
        for (int b = 0; b < 2; ++b)
#pragma unroll
            for (int m = 0; m < 4; ++m)
#pragma unroll
                for (int n = 0; n < 2; ++n) acc[a][b][m][n] = (f32x4){0.f, 0.f, 0.f, 0.f};
    bf16x8 At[4][2], B0[2][2], B1[2][2];
    const char* cA = (const char*)g.A + (size_t)cur.pm * tstep; const char* cB = (const char*)g.Bt + (size_t)cur.pn * tstep;
    S.a_ready(cur);
    if constexpr (SP2) {
        PG8_STAGE(PG8_SB(0, 0), cB, voffB); PG8_STAGE(PG8_SB(0, 1), cB + hstep, voffB); PG8_STAGE(PG8_SA(0, 0), cA, voffA); PG8_STAGE(PG8_SA(0, 1), cA + hstep, voffA);
        if (wr == 1) PG8_BAR;
        PG8_WAIT_V(2); PG8_BAR;
        PG8_STAGE(PG8_SB(1, 0), cB + kstep, voffB); PG8_STAGE(PG8_SA(1, 0), cA + kstep, voffA); PG8_STAGE(PG8_SB(1, 1), cB + hstep + kstep, voffB);
        PG8_WAIT_V(6); PG8_BAR;
    } else {
        PG8_STAGE(PG8_SB(0, 0), cB, voffB); PG8_STAGE(PG8_SA(0, 0), cA, voffA); PG8_STAGE(PG8_SB(0, 1), cB + hstep, voffB); PG8_STAGE(PG8_SA(0, 1), cA + hstep, voffA);
        if (wr == 1) PG8_BAR;
        PG8_WAIT_V(4); PG8_BAR;
        PG8_STAGE(PG8_SB(1, 0), cB + kstep, voffB); PG8_STAGE(PG8_SA(1, 0), cA + kstep, voffA); PG8_STAGE(PG8_SB(1, 1), cB + hstep + kstep, voffB);
        PG8_WAIT_V(6); PG8_BAR;
    }
    for (;;) {
        const bool has_next = S.next(ui + 1, nxt);
        const char* nA = has_next ? (const char*)g.A + (size_t)nxt.pm * tstep : cA; const char* nB = has_next ? (const char*)g.Bt + (size_t)nxt.pn * tstep : cB;
        for (int t = 0; t < nt; t += 2) {
            const bool last = (t == nt - 2);
            const char* a1 = cA + (size_t)(t + 1) * kstep;
            const char* a2 = last ? nA : cA + (size_t)(t + 2) * kstep; const char* b2 = last ? nB : cB + (size_t)(t + 2) * kstep;
            const char* a3 = a2 + kstep; const char* b3 = b2 + kstep;
            if (last && has_next) S.a_ready(nxt);
            if constexpr (SP2) {
            PG8_LDB(B0, 0, 0); PG8_LDB(B1, 0, 1); PG8_SCHED; PG8_LDA(At, 0, 0); PG8_STAGE(PG8_SA(1, 1), a1 + hstep, voffA);
            PG8_WAIT_V(8); PG8_WAIT_L(0); PG8_BAR; PG8_MMA(0, 0, At, B0); PG8_MMA(0, 1, At, B1); PG8_BAR; PG8_SCHED;
            PG8_LDA(At, 0, 1); PG8_STAGE(PG8_SB(0, 0), b2, voffB); PG8_STAGE(PG8_SB(0, 1), b2 + hstep, voffB); PG8_STAGE(PG8_SA(0, 0), a2, voffA);
            PG8_WAIT_V(8); PG8_WAIT_L(0); PG8_BAR; PG8_MMA(1, 0, At, B0); PG8_MMA(1, 1, At, B1); PG8_BAR; PG8_SCHED;
            PG8_LDB(B0, 1, 0); PG8_LDB(B1, 1, 1); PG8_SCHED; PG8_LDA(At, 1, 0); PG8_STAGE(PG8_SA(0, 1), a2 + hstep, voffA);
            PG8_WAIT_V(8); PG8_WAIT_L(0); PG8_BAR; PG8_MMA(0, 0, At, B0); PG8_MMA(0, 1, At, B1); PG8_BAR; PG8_SCHED;
            PG8_LDA(At, 1, 1); PG8_STAGE(PG8_SB(1, 0), b3, voffB); PG8_STAGE(PG8_SB(1, 1), b3 + hstep, voffB); PG8_STAGE(PG8_SA(1, 0), a3, voffA);
            PG8_WAIT_V(8); PG8_WAIT_L(0); PG8_BAR; PG8_MMA(1, 0, At, B0); PG8_MMA(1, 1, At, B1); PG8_BAR; PG8_SCHED;
            } else {
            PG8_LDB(B0, 0, 0); PG8_SCHED; PG8_LDA(At, 0, 0); PG8_STAGE(PG8_SA(1, 1), a1 + hstep, voffA);
            PG8_WAIT_L(8); PG8_BAR; PG8_WAIT_L(0); PG8_MMA(0, 0, At, B0); PG8_BAR; PG8_SCHED;
            PG8_LDB(B1, 0, 1); PG8_STAGE(PG8_SB(0, 0), b2, voffB);
            PG8_BAR; PG8_WAIT_L(0); PG8_MMA(0, 1, At, B1); PG8_BAR;
            PG8_LDA(At, 0, 1); PG8_STAGE(PG8_SA(0, 0), a2, voffA);
            PG8_BAR; PG8_WAIT_L(0); PG8_MMA(1, 0, At, B0); PG8_BAR; PG8_SCHED;
            PG8_STAGE(PG8_SB(0, 1), b2 + hstep, voffB);
            PG8_WAIT_V(6); PG8_BAR; PG8_MMA(1, 1, At, B1); PG8_BAR;
            PG8_LDB(B0, 1, 0); PG8_SCHED; PG8_LDA(At, 1, 0); PG8_STAGE(PG8_SA(0, 1), a2 + hstep, voffA);
            PG8_WAIT_L(8); PG8_BAR; PG8_WAIT_L(0); PG8_MMA(0, 0, At, B0); PG8_BAR; PG8_SCHED;
            PG8_LDB(B1, 1, 1); PG8_STAGE(PG8_SB(1, 0), b3, voffB);
            PG8_BAR; PG8_WAIT_L(0); PG8_MMA(0, 1, At, B1); PG8_BAR;
            PG8_LDA(At, 1, 1); PG8_STAGE(PG8_SA(1, 0), a3, voffA);
            PG8_BAR; PG8_WAIT_L(0); PG8_MMA(1, 0, At, B0); PG8_BAR; PG8_SCHED;
            PG8_STAGE(PG8_SB(1, 1), b3 + hstep, voffB);
            PG8_WAIT_V(6); PG8_BAR; PG8_MMA(1, 1, At, B1); PG8_BAR;
            }
        }
        if constexpr (ALIGN_EPI) { if (wr == 0) PG8_BAR; }
        if constexpr (!Epi::AFTER_DRAIN) { E(acc, cur, wr, wc, fr, fq); S.done(cur); }
        if (!has_next) break;
#pragma unroll
        for (int a = 0; a < 2; ++a)
#pragma unroll
            for (int b = 0; b < 2; ++b)
#pragma unroll
                for (int m = 0; m < 4; ++m)
#pragma unroll
                    for (int n = 0; n < 2; ++n) acc[a][b][m][n] = (f32x4){0.f, 0.f, 0.f, 0.f};
        cur = nxt; cA = nA; cB = nB; ++ui;
        if constexpr (ALIGN_EPI) { if (wr == 1) PG8_BAR; }
    }
    PG8_WAIT_V(0);
    if constexpr (!ALIGN_EPI) { if (wr == 0) PG8_BAR; }
    PG8_BAR;
    if constexpr (Epi::AFTER_DRAIN) { E.fused(acc, cur, wr, wc, fr, fq, lds, wid, lane); S.done(cur); }
#undef PG8_SA
#undef PG8_SB
#undef PG8_STAGE
#undef PG8_LDA
#undef PG8_LDB
#undef PG8_MMA
#undef PG8_WAIT_V
#undef PG8_WAIT_L
#undef PG8_BAR
#undef PG8_SCHED
}
}

constexpr int NWAVES = 8, NTHR = 512;
constexpr int BATCH = 8, SEQ = 2048, DM = 1024, DIN = 1932, ZP = 2048, FF = 4096, DEPTH = 2;
constexpr int M = BATCH * SEQ;
constexpr float NORM_EPS = 1e-6f;
constexpr int ZC_CVAL = 0, ZC_CGATE = 256, ZC_POOL = 512, ZC_SU = 768, ZC_SV = 1024, ZC_Q = 1280, ZC_KC = 1536, ZC_VC = 1600, ZC_KS = 1664, ZC_VS = 1728, ZC_KW = 1792, ZC_VW = 1856, ZC_G = 1920;
constexpr int MC_CONV = 0, MC_POOL = 256, MC_SGU = 512, MC_NSA = 768;
constexpr size_t MiB = 1u << 20, KiB = 1u << 10;
constexpr size_t WS_WIN = 1 * MiB, WS_WOUT = 9 * MiB, WS_W1 = 13 * MiB, WS_W2 = 29 * MiB, WS_CW1 = 45 * MiB;
constexpr size_t WS_SGUW = 46 * MiB, WS_POOLW = 46 * MiB + 256 * KiB, WS_C0 = 46 * MiB + 384 * KiB, WS_COS = 46 * MiB + 512 * KiB, WS_SIN = 47 * MiB;
constexpr size_t WS_KCMP = 47 * MiB + 512 * KiB, WS_VCMP = 47 * MiB + 640 * KiB;
constexpr size_t WS_XNA = 48 * MiB, WS_Y2 = 48 * MiB;
constexpr size_t WS_Z = 128 * MiB, WS_Y1 = 128 * MiB;
constexpr size_t WS_MIX = 192 * MiB, WS_XNB = 224 * MiB;
constexpr size_t WS_F = 128 * MiB, WS_END = 256 * MiB;
constexpr int LDS_BYTES = 147456;

typedef unsigned short bf16;
typedef unsigned v4u __attribute__((ext_vector_type(4)));
typedef unsigned v2u __attribute__((ext_vector_type(2)));
typedef float f32x4 __attribute__((ext_vector_type(4)));
typedef float f32x2 __attribute__((ext_vector_type(2)));
typedef short bf16x8 __attribute__((ext_vector_type(8)));
typedef short s16x4 __attribute__((ext_vector_type(4)));
#define LAS __attribute__((address_space(3)))
#define MFMA16(a, b, c) __builtin_amdgcn_mfma_f32_16x16x32_bf16((a), (b), (c), 0, 0, 0)

__device__ __forceinline__ unsigned f2bf(float f) { unsigned u = __builtin_bit_cast(unsigned, f); return (u + 0x7fffu + ((u >> 16) & 1u)) >> 16; }
__device__ __forceinline__ unsigned pk2(float lo, float hi) { return f2bf(lo) | (f2bf(hi) << 16); }
__device__ __forceinline__ float bflo(unsigned w) { return __builtin_bit_cast(float, w << 16); }
__device__ __forceinline__ float bfhi(unsigned w) { return __builtin_bit_cast(float, w & 0xffff0000u); }
__device__ __forceinline__ float wave_sum(float v) {
#pragma unroll
    for (int o = 1; o < 64; o <<= 1) v += __shfl_xor(v, o);
    return v;
}
__device__ __forceinline__ float sigmoidf_(float x) { return 1.0f / (1.0f + __expf(-x)); }
__device__ __forceinline__ float gelu_tanh(float x) {
    const float y = 0.7978845608028654f * (x + 0.044715f * x * x * x);
    const float t = 1.0f - 2.0f / (__expf(2.0f * y) + 1.0f);
    return 0.5f * x * (1.0f + t);
}

struct Args { const void* in[26]; float* out; unsigned char* ws; int ph_lo, ph_hi; };
typedef const __attribute__((address_space(4))) Args CA;
__device__ __forceinline__ CA* get_args() { CA* p = (CA*)__builtin_amdgcn_kernarg_segment_ptr(); asm volatile("" : "+s"(p)); return p; }
#define ARGS (*get_args())

struct Ctx {
    unsigned char* lds; unsigned char* ws;
    int tid, lane, wave, G, bid;
};

__device__ __forceinline__ Ctx fresh(const Ctx& C0) { Ctx C = C0; int t = C0.tid; asm volatile("" : "+v"(t)); C.tid = t; C.lane = t & 63; C.wave = __builtin_amdgcn_readfirstlane(t >> 6); int b = C0.bid; asm volatile("" : "+s"(b)); C.bid = b; unsigned char* w = C0.ws; asm volatile("" : "+s"(w)); C.ws = w; return C; }
__device__ __forceinline__ void p0_transpose_item(const float* W, int K, int Nsrc, int Npad, bf16* WT, float* scr, int item, int lane) {
    const int nblk = Npad / 32, kb = item / nblk, nb = item % nblk, k0 = 64 * kb, n0 = 32 * nb;
    const int nn = n0 + (lane & 31);
#pragma unroll 8
    for (int i = 0; i < 32; ++i) { const int kk = 2 * i + (lane >> 5); scr[kk * 33 + (lane & 31)] = (nn < Nsrc) ? W[(size_t)(k0 + kk) * Nsrc + nn] : 0.f; }
    asm volatile("s_waitcnt lgkmcnt(0)" ::: "memory");
    const int c = lane & 7;
#pragma unroll
    for (int j = 0; j < 4; ++j) { const int n = (lane >> 3) + 8 * j; const float* s = scr + (8 * c) * 33 + n;
        v4u o; o.x = pk2(s[0 * 33], s[1 * 33]); o.y = pk2(s[2 * 33], s[3 * 33]); o.z = pk2(s[4 * 33], s[5 * 33]); o.w = pk2(s[6 * 33], s[7 * 33]);
        *(v4u*)(WT + (size_t)(n0 + n) * K + k0 + 8 * c) = o; }
    asm volatile("s_waitcnt lgkmcnt(0)" ::: "memory");
}
__device__ __forceinline__ void norm_row(const float* y, const float* xin, float* xout, const float* gpost, const float* gnext, bf16* xn, int lane) {
    f32x4 v[4];
#pragma unroll
    for (int j = 0; j < 4; ++j) v[j] = *((const f32x4*)xin + lane + 64 * j);
    if (y) {
        f32x4 yv[4]; float s = 0.f;
#pragma unroll
        for (int j = 0; j < 4; ++j) { yv[j] = *((const f32x4*)y + lane + 64 * j); s += (yv[j].x * yv[j].x + yv[j].y * yv[j].y) + (yv[j].z * yv[j].z + yv[j].w * yv[j].w); }
        const float r = 1.0f / sqrtf(wave_sum(s) * (1.f / DM) + NORM_EPS);
#pragma unroll
        for (int j = 0; j < 4; ++j) { const f32x4 g = *((const f32x4*)gpost + lane + 64 * j); v[j] = v[j] + yv[j] * r * g; *((f32x4*)xout + lane + 64 * j) = v[j]; }
    }
    if (gnext) {
        float s = 0.f;
#pragma unroll
        for (int j = 0; j < 4; ++j) s += (v[j].x * v[j].x + v[j].y * v[j].y) + (v[j].z * v[j].z + v[j].w * v[j].w);
        const float r = 1.0f / sqrtf(wave_sum(s) * (1.f / DM) + NORM_EPS);
#pragma unroll
        for (int j = 0; j < 4; ++j) { const f32x4 g = *((const f32x4*)gnext + lane + 64 * j); const f32x4 o = v[j] * r * g;
            v2u w; w.x = pk2(o.x, o.y); w.y = pk2(o.z, o.w); *((v2u*)xn + lane + 64 * j) = w; }
    }
}
__device__ __forceinline__ void norm_phase(const Ctx& C, const float* Y, const float* xin, float* xout, const float* gpost, const float* gnext, bf16* XN) {
    const int gw = C.bid * NWAVES + C.wave, NGW = C.G * NWAVES;
    for (int m = gw; m < M; m += NGW) norm_row(Y ? Y + (size_t)m * DM : nullptr, xin + (size_t)m * DM, xout ? xout + (size_t)m * DM : nullptr, gpost, gnext, XN + (size_t)m * DM, C.lane);
}

__device__ __forceinline__ void p0_prologue(const Ctx& C, CA& A) {
    float* scr = (float*)(C.lds + C.wave * 16384);
    unsigned char* ws = C.ws;
    const int gw = C.bid * NWAVES + C.wave, NGW = C.G * NWAVES;
    constexpr int I_IN = (DM / 64) * (ZP / 32), I_OUT = (DM / 64) * (DM / 32), I_1 = (DM / 64) * (FF / 32), I_2 = (FF / 64) * (DM / 32), I_CW = (2048 / 64) * (64 / 32), I_PW = 2;
    constexpr int PER_L = I_IN + I_OUT + I_1 + I_2 + 2 * I_CW + 4 * I_PW;
    for (int it = gw; it < DEPTH * PER_L; it += NGW) {
        const int l = it / PER_L; int r = it % PER_L;
        if (r < I_IN) { p0_transpose_item((const float*)A.in[6] + (size_t)l * DM * DIN, DM, DIN, ZP, (bf16*)(ws + WS_WIN) + (size_t)l * ZP * DM, scr, r, C.lane); continue; } r -= I_IN;
        if (r < I_OUT) { p0_transpose_item((const float*)A.in[23] + (size_t)l * DM * DM, DM, DM, DM, (bf16*)(ws + WS_WOUT) + (size_t)l * DM * DM, scr, r, C.lane); continue; } r -= I_OUT;
        if (r < I_1) { p0_transpose_item((const float*)A.in[24] + (size_t)l * DM * FF, DM, FF, FF, (bf16*)(ws + WS_W1) + (size_t)l * FF * DM, scr, r, C.lane); continue; } r -= I_1;
        if (r < I_2) { p0_transpose_item((const float*)A.in[25] + (size_t)l * FF * DM, FF, DM, DM, (bf16*)(ws + WS_W2) + (size_t)l * DM * FF, scr, r, C.lane); continue; } r -= I_2;
        if (r < 2 * I_CW) { const int kv = r / I_CW; p0_transpose_item((const float*)A.in[kv ? 21 : 18] + (size_t)l * 2048 * 64, 2048, 64, 64, (bf16*)(ws + WS_CW1) + (size_t)(l * 2 + kv) * 64 * 2048, scr, r % I_CW, C.lane); continue; } r -= 2 * I_CW;
        { const int gi = r / I_PW; p0_transpose_item((const float*)A.in[11] + (size_t)(l * 4 + gi) * 4096, 64, 64, 64, (bf16*)(ws + WS_POOLW) + (size_t)(l * 4 + gi) * 4096, scr, r % I_PW, C.lane); }
    }
    { const float* sw = (const float*)A.in[15]; bf16* dst = (bf16*)(ws + WS_SGUW);
      for (int i = C.bid * NTHR + C.tid; i < DEPTH * 4 * 128 * 128; i += C.G * NTHR) { const int s = i & 127, t = (i >> 7) & 127; dst[i] = (bf16)f2bf(s <= t ? sw[i] : 0.f); } }
    if (gw < DEPTH * 2) { const int l = gw >> 1, kv = gw & 1; const float* pe = (const float*)A.in[kv ? 20 : 17] + (size_t)l * 2048; const float* w1 = (const float*)A.in[kv ? 21 : 18] + (size_t)l * 2048 * 64;
        float s = 0.f; for (int k = 0; k < 2048; ++k) s += pe[k] * w1[(size_t)k * 64 + C.lane];
        ((float*)(ws + WS_C0))[(l * 2 + kv) * 64 + C.lane] = s; }
    { const int* pos = (const int*)A.in[1]; float* ct = (float*)(ws + WS_COS); float* st = (float*)(ws + WS_SIN);
      for (int i = C.bid * NTHR + C.tid; i < M * 8; i += C.G * NTHR) { const int m = i >> 3, k = i & 7;
          const double inv = k == 0 ? 1.0 : k == 1 ? 0.19392274474868576 : k == 2 ? 0.03760603093086393 : k == 3 ? 0.007292664737217109 : k == 4 ? 0.001414213562373095 : k == 5 ? 0.0002742481756762073 : k == 6 ? 5.318295896944988e-05 : 1.031338537721246e-05;
          const double rev = (double)pos[m] * inv * 0.15915494309189535; const float fr = (float)(rev - floor(rev));
          ct[i] = __builtin_amdgcn_cosf(fr); st[i] = __builtin_amdgcn_sinf(fr); } }
    norm_phase(C, nullptr, (const float*)A.in[0], nullptr, nullptr, (const float*)A.in[2], (bf16*)(ws + WS_XNB));
}

__device__ __forceinline__ void unpack8(const v4u w, float* f) { f[0] = bflo(w.x); f[1] = bfhi(w.x); f[2] = bflo(w.y); f[3] = bfhi(w.y); f[4] = bflo(w.z); f[5] = bfhi(w.z); f[6] = bflo(w.w); f[7] = bfhi(w.w); }

__device__ __forceinline__ void conv_unit(const Ctx& C, CA& A, int l, int u) {
    const int b = u >> 5, t0 = (u & 31) * 64, tid = C.tid;
    float* hb = (float*)C.lds;
    const bf16* Z = (const bf16*)(C.ws + WS_Z) + (size_t)b * SEQ * ZP;
    for (int r = tid >> 5; r < 94; r += 16) {
        const int t = t0 - 30 + r, c8 = (tid & 31) * 8; float hv[8];
        if (t >= 0) { const v4u a = *(const v4u*)(Z + (size_t)t * ZP + ZC_CVAL + c8), gt = *(const v4u*)(Z + (size_t)t * ZP + ZC_CGATE + c8); float av[8], gv[8]; unpack8(a, av); unpack8(gt, gv);
#pragma unroll
            for (int j = 0; j < 8; ++j) hv[j] = av[j] * sigmoidf_(gv[j]); }
        else {
#pragma unroll
            for (int j = 0; j < 8; ++j) hv[j] = 0.f; }
        *(f32x4*)(hb + r * 256 + c8) = (f32x4){hv[0], hv[1], hv[2], hv[3]}; *(f32x4*)(hb + r * 256 + c8 + 4) = (f32x4){hv[4], hv[5], hv[6], hv[7]};
    }
    __syncthreads();
    const int c = tid & 255, base = (tid >> 8) * 32;
    const float* cw = (const float*)A.in[7] + (size_t)l * 31 * 256; const float bias = ((const float*)A.in[8])[l * 256 + c];
    float w[31];
#pragma unroll
    for (int k = 0; k < 31; ++k) w[k] = cw[k * 256 + c];
    float o[32];
#pragma unroll
    for (int ch = 0; ch < 4; ++ch) {
        float hv[38];
#pragma unroll
        for (int r = 0; r < 38; ++r) hv[r] = hb[(base + ch * 8 + r) * 256 + c];
#pragma unroll
        for (int i = 0; i < 8; ++i) { float acc = bias;
#pragma unroll
            for (int k = 0; k < 31; ++k) acc += w[k] * hv[i + k];
            o[ch * 8 + i] = acc; }
    }
    __syncthreads();
    float* ob = (float*)C.lds;
#pragma unroll
    for (int i = 0; i < 32; ++i) ob[(base + i) * 256 + c] = o[i];
    __syncthreads();
    const f32x4 g = *((const f32x4*)((const float*)A.in[9] + l * 256) + C.lane), bb = *((const f32x4*)((const float*)A.in[10] + l * 256) + C.lane);
    bf16* MIX = (bf16*)(C.ws + WS_MIX);
#pragma unroll 2
    for (int i = 0; i < 8; ++i) { const int tok = C.wave * 8 + i; f32x4 v = *((const f32x4*)(ob + tok * 256) + C.lane);
        const float mu = wave_sum((v.x + v.y) + (v.z + v.w)) * (1.f / 256.f); v = v - mu;
        const float var = wave_sum((v.x * v.x + v.y * v.y) + (v.z * v.z + v.w * v.w)) * (1.f / 256.f); const float rstd = 1.0f / sqrtf(var + NORM_EPS);
        f32x4 y = v * rstd * g + bb; y.x *= sigmoidf_(y.x); y.y *= sigmoidf_(y.y); y.z *= sigmoidf_(y.z); y.w *= sigmoidf_(y.w);
        v2u wv; wv.x = pk2(y.x, y.y); wv.y = pk2(y.z, y.w); *(v2u*)(MIX + (size_t)(b * SEQ + t0 + tok) * DM + MC_CONV + C.lane * 4) = wv; }
    __syncthreads();
}

__device__ __forceinline__ void pool_unit(const Ctx& C, CA& A, int l, int u) {
    const int b = u >> 5, t0 = (u & 31) * 64, tid = C.tid, lane = C.lane;
    float* pb = (float*)C.lds;
    bf16* mb = (bf16*)(C.lds + 81920);
    const bf16* Z = (const bf16*)(C.ws + WS_Z) + (size_t)b * SEQ * ZP;
    for (int r = tid >> 5; r < 79; r += 16) {
        const int t = t0 - 15 + r, c8 = (tid & 31) * 8; float hv[8];
        if (t >= 0) { const v4u a = *(const v4u*)(Z + (size_t)t * ZP + ZC_POOL + c8); unpack8(a, hv); }
        else {
#pragma unroll
            for (int j = 0; j < 8; ++j) hv[j] = 0.f; }
        *(f32x4*)(pb + r * 256 + c8) = (f32x4){hv[0], hv[1], hv[2], hv[3]}; *(f32x4*)(pb + r * 256 + c8 + 4) = (f32x4){hv[4], hv[5], hv[6], hv[7]};
    }
    __syncthreads();
    { const int c = tid & 255, base = (tid >> 8) * 32, gi = c >> 6, win = 2 << gi;
      float s = 0.f; for (int k = 0; k < win; ++k) s += pb[(base + 15 - k) * 256 + c];
      for (int i = 0; i < 32; ++i) { const int tok = base + i; const float cur = pb[(tok + 15) * 256 + c];
          if (i > 0) s += cur - pb[(tok + 15 - win) * 256 + c];
          const int t = t0 + tok; const int cnt = (t + 1 < win) ? (t + 1) : win;
          mb[tok * 264 + c] = (bf16)f2bf(s / (float)cnt - cur); } }
    __syncthreads();
    { const int gi = C.wave >> 1, mt0 = (C.wave & 1) * 2, c16 = lane & 15, g = lane >> 4;
      const bf16* wT = (const bf16*)(C.ws + WS_POOLW) + (size_t)(l * 4 + gi) * 4096;
      f32x4 acc[2][4];
#pragma unroll
      for (int mi = 0; mi < 2; ++mi)
#pragma unroll
          for (int nt = 0; nt < 4; ++nt) acc[mi][nt] = (f32x4){0.f, 0.f, 0.f, 0.f};
#pragma unroll
      for (int ks = 0; ks < 2; ++ks) { bf16x8 mf[2];
#pragma unroll
          for (int mi = 0; mi < 2; ++mi) mf[mi] = *(const bf16x8*)(mb + ((mt0 + mi) * 16 + c16) * 264 + gi * 64 + ks * 32 + g * 8);
#pragma unroll
          for (int nt = 0; nt < 4; ++nt) { const bf16x8 wf = *(const bf16x8*)(wT + (nt * 16 + c16) * 64 + ks * 32 + g * 8);
#pragma unroll
              for (int mi = 0; mi < 2; ++mi) acc[mi][nt] = MFMA16(wf, mf[mi], acc[mi][nt]); } }
      const float* ps = (const float*)A.in[12] + l * 256 + gi * 64; bf16* MIX = (bf16*)(C.ws + WS_MIX);
#pragma unroll
      for (int mi = 0; mi < 2; ++mi)
#pragma unroll
          for (int nt = 0; nt < 4; ++nt) { const int tok = (mt0 + mi) * 16 + c16, d = nt * 16 + g * 4; const f32x4 sc = *(const f32x4*)(ps + d); const f32x4 o = acc[mi][nt] * sc;
              v2u wv; wv.x = pk2(o.x, o.y); wv.y = pk2(o.z, o.w); *(v2u*)(MIX + (size_t)(b * SEQ + t0 + tok) * DM + MC_POOL + gi * 64 + d) = wv; } }
    __syncthreads();
}

__device__ __forceinline__ void sgu_unit(const Ctx& C, CA& A, int l, int u) {
    const int b = u >> 5, ck = (u & 31) >> 1, hp = u & 1, t0 = ck * 128, lane = C.lane, w = C.wave;
    bf16* vT = (bf16*)C.lds;
    const bf16* Z = (const bf16*)(C.ws + WS_Z) + (size_t)(b * SEQ + t0) * ZP;
    { const f32x4 g = *((const f32x4*)((const float*)A.in[13] + l * 256) + lane), bb = *((const f32x4*)((const float*)A.in[14] + l * 256) + lane);
#pragma unroll 2
      for (int i = 0; i < 16; ++i) { const int tok = w * 16 + i; const v2u raw = *(const v2u*)(Z + (size_t)tok * ZP + ZC_SV + lane * 4);
          f32x4 v = (f32x4){gelu_tanh(bflo(raw.x)), gelu_tanh(bfhi(raw.x)), gelu_tanh(bflo(raw.y)), gelu_tanh(bfhi(raw.y))};
          const float mu = wave_sum((v.x + v.y) + (v.z + v.w)) * (1.f / 256.f); v = v - mu;
          const float var = wave_sum((v.x * v.x + v.y * v.y) + (v.z * v.z + v.w * v.w)) * (1.f / 256.f); const float rstd = 1.0f / sqrtf(var + NORM_EPS);
          const f32x4 y = v * rstd * g + bb;
          if ((lane >> 5) == hp) { const int cl = (lane & 31) * 4; vT[(cl + 0) * 136 + tok] = (bf16)f2bf(y.x); vT[(cl + 1) * 136 + tok] = (bf16)f2bf(y.y); vT[(cl + 2) * 136 + tok] = (bf16)f2bf(y.z); vT[(cl + 3) * 136 + tok] = (bf16)f2bf(y.w); } } }
    __syncthreads();
    { const int c16 = lane & 15, g = lane >> 4, nks = ((16 * w + 15) >> 5) + 1, tok = w * 16 + c16;
      bf16* MIX = (bf16*)(C.ws + WS_MIX);
#pragma unroll
      for (int hh = 0; hh < 2; ++hh) { const int h = hp * 2 + hh; const bf16* Wh = (const bf16*)(C.ws + WS_SGUW) + (size_t)(l * 4 + h) * 128 * 128;
          f32x4 acc[4];
#pragma unroll
          for (int dt = 0; dt < 4; ++dt) acc[dt] = (f32x4){0.f, 0.f, 0.f, 0.f};
#pragma unroll
          for (int ks = 0; ks < 4; ++ks) if (ks < nks) { const bf16x8 wf = *(const bf16x8*)(Wh + (size_t)tok * 128 + ks * 32 + g * 8);
#pragma unroll
              for (int dt = 0; dt < 4; ++dt) { const bf16x8 vf = *(const bf16x8*)(vT + (hh * 64 + dt * 16 + c16) * 136 + ks * 32 + g * 8); acc[dt] = MFMA16(vf, wf, acc[dt]); } }
          const float bias = ((const float*)A.in[16])[(l * 4 + h) * 128 + tok];
#pragma unroll
          for (int dt = 0; dt < 4; ++dt) { const int d = dt * 16 + g * 4; const v2u raw = *(const v2u*)(Z + (size_t)tok * ZP + ZC_SU + h * 64 + d);
              const float o0 = gelu_tanh(bflo(raw.x)) * (acc[dt][0] + bias), o1 = gelu_tanh(bfhi(raw.x)) * (acc[dt][1] + bias), o2 = gelu_tanh(bflo(raw.y)) * (acc[dt][2] + bias), o3 = gelu_tanh(bfhi(raw.y)) * (acc[dt][3] + bias);
              v2u wv; wv.x = pk2(o0, o1); wv.y = pk2(o2, o3); *(v2u*)(MIX + (size_t)(b * SEQ + t0 + tok) * DM + MC_SGU + h * 64 + d) = wv; } } }
    __syncthreads();
}

__device__ __forceinline__ void cmp_unit(const Ctx& C, CA& A, int l, int u) {
    const int b = u >> 4, kv = (u >> 3) & 1, nt = u & 7, lane = C.lane, w = C.wave, tid = C.tid;
    const int c16 = lane & 15, g = lane >> 4, n = nt * 16 + c16;
    const bf16* Z = (const bf16*)(C.ws + WS_Z) + (size_t)b * SEQ * ZP + (kv ? ZC_VC : ZC_KC);
    const bf16* W1T = (const bf16*)(C.ws + WS_CW1) + (size_t)(l * 2 + kv) * 64 * 2048;
    f32x4 acc[4];
#pragma unroll
    for (int et = 0; et < 4; ++et) acc[et] = (f32x4){0.f, 0.f, 0.f, 0.f};
#pragma unroll
    for (int i = 0; i < 8; ++i) { const int ll = 4 * w + (i >> 1), d0 = (i & 1) * 32;
        bf16x8 xf = (bf16x8){0, 0, 0, 0, 0, 0, 0, 0};
        if (n < 127) xf = *(const bf16x8*)(Z + (size_t)(16 * n + ll) * ZP + d0 + g * 8);
#pragma unroll
        for (int et = 0; et < 4; ++et) { const bf16x8 wf = *(const bf16x8*)(W1T + (size_t)(et * 16 + c16) * 2048 + ll * 64 + d0 + g * 8); acc[et] = MFMA16(wf, xf, acc[et]); } }
    float* red = (float*)C.lds;
    float* hid = (float*)(C.lds + 34816);
    float* ob = (float*)(C.lds + 34816 + 4160);
#pragma unroll
    for (int et = 0; et < 4; ++et)
#pragma unroll
        for (int j = 0; j < 4; ++j) red[(w * 64 + et * 16 + g * 4 + j) * 17 + c16] = acc[et][j];
    __syncthreads();
    const float* c0 = (const float*)(C.ws + WS_C0) + (l * 2 + kv) * 64;
#pragma unroll
    for (int q = 0; q < 2; ++q) { const int idx = tid + 512 * q, e = idx & 63, nl = idx >> 6; float s = c0[e];
#pragma unroll
        for (int ww = 0; ww < 8; ++ww) s += red[(ww * 64 + e) * 17 + nl];
        hid[nl * 65 + e] = gelu_tanh(s); }
    __syncthreads();
    const int nl = tid >> 5, e2 = (tid & 31) * 2;
    { const float* w2 = (const float*)A.in[kv ? 22 : 19] + (size_t)l * 4096; float o0 = 0.f, o1 = 0.f;
      for (int e = 0; e < 64; ++e) { const float hv = hid[nl * 65 + e]; const f32x2 wv = *(const f32x2*)(w2 + e * 64 + e2); o0 += hv * wv.x; o1 += hv * wv.y; }
      ob[nl * 64 + e2] = o0; ob[nl * 64 + e2 + 1] = o1; }
    __syncthreads();
    { const int nn = nt * 16 + nl; float v0 = ob[nl * 64 + e2], v1 = ob[nl * 64 + e2 + 1];
      if (nn >= 127) { v0 = 0.f; v1 = 0.f; }
      else if (kv == 0 && e2 < 16) { const size_t tr = (size_t)(b * SEQ + 16 * nn + 31) * 8; const float* ct = (const float*)(C.ws + WS_COS) + tr; const float* st = (const float*)(C.ws + WS_SIN) + tr;
#pragma unroll
          for (int q = 0; q < 2; ++q) { const int e = e2 + q, i = e & 7; const float x1 = ob[nl * 64 + i], x2 = ob[nl * 64 + i + 8], cc = ct[i], ss = st[i];
              const float r = (e < 8) ? (x1 * cc - x2 * ss) : (x2 * cc + x1 * ss); if (q == 0) v0 = r; else v1 = r; } }
      bf16* dst = (bf16*)(C.ws + (kv ? WS_VCMP : WS_KCMP)) + (size_t)(b * 128 + nn) * 64 + e2;
      *(unsigned*)dst = pk2(v0, v1); }
    __syncthreads();
}

__device__ __forceinline__ void rope_pass(const Ctx& C) {
    bf16* Z = (bf16*)(C.ws + WS_Z); const float* ct = (const float*)(C.ws + WS_COS); const float* st = (const float*)(C.ws + WS_SIN);
    for (int idx = C.bid * NTHR + C.tid; idx < M * 6; idx += C.G * NTHR) { const int m = idx / 6, vec = idx - m * 6;
        const int col = vec < 4 ? ZC_Q + vec * 64 : (vec == 4 ? ZC_KS : ZC_KW);
        bf16* p = Z + (size_t)m * ZP + col; const v4u a = *(const v4u*)p, bq = *(const v4u*)(p + 8); float x1[8], x2[8], cc[8], ss[8]; unpack8(a, x1); unpack8(bq, x2);
        { const f32x4 c0 = *(const f32x4*)(ct + (size_t)m * 8), c1 = *(const f32x4*)(ct + (size_t)m * 8 + 4), s0 = *(const f32x4*)(st + (size_t)m * 8), s1 = *(const f32x4*)(st + (size_t)m * 8 + 4);
          cc[0] = c0.x; cc[1] = c0.y; cc[2] = c0.z; cc[3] = c0.w; cc[4] = c1.x; cc[5] = c1.y; cc[6] = c1.z; cc[7] = c1.w; ss[0] = s0.x; ss[1] = s0.y; ss[2] = s0.z; ss[3] = s0.w; ss[4] = s1.x; ss[5] = s1.y; ss[6] = s1.z; ss[7] = s1.w; }
        float y1[8], y2[8];
#pragma unroll
        for (int i = 0; i < 8; ++i) { y1[i] = x1[i] * cc[i] - x2[i] * ss[i]; y2[i] = x2[i] * cc[i] + x1[i] * ss[i]; }
        v4u o1, o2; o1.x = pk2(y1[0], y1[1]); o1.y = pk2(y1[2], y1[3]); o1.z = pk2(y1[4], y1[5]); o1.w = pk2(y1[6], y1[7]); o2.x = pk2(y2[0], y2[1]); o2.y = pk2(y2[2], y2[3]); o2.z = pk2(y2[4], y2[5]); o2.w = pk2(y2[6], y2[7]);
        *(v4u*)p = o1; *(v4u*)(p + 8) = o2; }
}

__device__ __forceinline__ int opaque(int v) { asm volatile("" : "+v"(v)); return v; }
constexpr float SM_C = 0.18033688011112042f;
constexpr float NEG_BIG = -1.0e30f;
constexpr int KV_PITCH = 72;
constexpr int A_KV = 0, KVBUF_BYTES = 2 * 64 * KV_PITCH * 2  ;
constexpr int A_KC = 2 * KVBUF_BYTES  , A_VCT = A_KC + 128 * KV_PITCH * 2  , VCT_PITCH = 136;
constexpr int A_IMP = A_VCT + 64 * VCT_PITCH * 2  , A_VAL = A_IMP + 4 * 64 * 33 * 4  , A_SEL = A_VAL + 64 * 33 * 4  , A_BL = A_SEL + 256, A_END3 = A_BL + 256;
static_assert(A_END3 <= 131072, "P3 LDS map");

__device__ __forceinline__ void attn_block(const bf16* Ks, const bf16* Vt, const bf16x8 (&qf)[2][2], f32x4 (&O)[2][4], float (&mrun)[2], float (&lrun)[2], const int (&lo)[2], const int (&hi)[2], int c16, int g) {
    f32x4 sc[2][4];
#pragma unroll
    for (int kt = 0; kt < 4; ++kt) { const bf16x8 k0 = *(const bf16x8*)(Ks + (kt * 16 + c16) * KV_PITCH + g * 8), k1 = *(const bf16x8*)(Ks + (kt * 16 + c16) * KV_PITCH + 32 + g * 8);
#pragma unroll
        for (int s = 0; s < 2; ++s) { sc[s][kt] = MFMA16(k0, qf[s][0], ((f32x4){0.f, 0.f, 0.f, 0.f})); sc[s][kt] = MFMA16(k1, qf[s][1], sc[s][kt]); } }
#pragma unroll
    for (int s = 0; s < 2; ++s) {
        float mx = NEG_BIG;
#pragma unroll
        for (int kt = 0; kt < 4; ++kt)
#pragma unroll
            for (int j = 0; j < 4; ++j) { const bool ok = (kt * 16 + j >= lo[s]) && (kt * 16 + j <= hi[s]); const float v = ok ? sc[s][kt][j] * SM_C : NEG_BIG; sc[s][kt][j] = v; mx = fmaxf(mx, v); }
        mx = fmaxf(mx, __shfl_xor(mx, 16)); mx = fmaxf(mx, __shfl_xor(mx, 32));
        const float mnew = fmaxf(mrun[s], mx); const float alpha = exp2f(mrun[s] - mnew); float ps = 0.f;
#pragma unroll
        for (int kt = 0; kt < 4; ++kt)
#pragma unroll
            for (int j = 0; j < 4; ++j) { const float v = sc[s][kt][j]; const float p = (v > -1.0e29f) ? exp2f(v - mnew) : 0.f; sc[s][kt][j] = p; ps += p; }
        ps += __shfl_xor(ps, 16); ps += __shfl_xor(ps, 32);
        lrun[s] = lrun[s] * alpha + ps; mrun[s] = mnew;
#pragma unroll
        for (int dt = 0; dt < 4; ++dt) O[s][dt] = O[s][dt] * alpha;
    }
#pragma unroll
    for (int kk = 0; kk < 2; ++kk) { bf16x8 pf[2];
#pragma unroll
        for (int s = 0; s < 2; ++s) { const f32x4 a = sc[s][2 * kk], bq = sc[s][2 * kk + 1]; v4u t; t.x = pk2(a[0], a[1]); t.y = pk2(a[2], a[3]); t.z = pk2(bq[0], bq[1]); t.w = pk2(bq[2], bq[3]); pf[s] = __builtin_bit_cast(bf16x8, t); }
#pragma unroll
        for (int dt = 0; dt < 4; ++dt) { const bf16* vp = Vt + (dt * 16 + c16) * KV_PITCH + (2 * kk) * 16 + g * 4; const v2u v0 = *(const v2u*)vp, v1 = *(const v2u*)(vp + 16);
            v4u t; t.x = v0.x; t.y = v0.y; t.z = v1.x; t.w = v1.y; const bf16x8 vf = __builtin_bit_cast(bf16x8, t);
#pragma unroll
            for (int s = 0; s < 2; ++s) O[s][dt] = MFMA16(vf, pf[s], O[s][dt]); } }
}

__device__ __forceinline__ void attn_branch(const Ctx& C, const bf16* Zb, int type, int nb, int qb, const bf16x8 (&qf)[2][2], const float (&gate)[2], f32x4 (&out)[2][4], int th) {
    const int tid = opaque(C.tid), lane = tid & 63, c16 = lane & 15, g = lane >> 4;
    const int* bl = (const int*)(C.lds + A_BL); const unsigned* selm = (const unsigned*)(C.lds + A_SEL);
    const int kcol = type ? ZC_KS : ZC_KW, vcol = type ? ZC_VS : ZC_VW;
    const int skey = tid >> 3, soct = tid & 7;
    f32x4 O[2][4]; float mrun[2], lrun[2];
#pragma unroll
    for (int s = 0; s < 2; ++s) { mrun[s] = NEG_BIG; lrun[s] = 0.f;
#pragma unroll
        for (int dt = 0; dt < 4; ++dt) O[s][dt] = (f32x4){0.f, 0.f, 0.f, 0.f}; }
    unsigned sm[2]; sm[0] = selm[th * 32 + c16]; sm[1] = selm[th * 32 + 16 + c16];
    v4u kreg, vreg;
    if (nb > 0) { const int J = bl[0]; const bf16* src = Zb + (size_t)(J * 64 + skey) * ZP + soct * 8; kreg = *(const v4u*)(src + kcol); vreg = *(const v4u*)(src + vcol); }
    if (nb > 0) { bf16* Ks = (bf16*)(C.lds + A_KV); bf16* Vt = Ks + 64 * KV_PITCH;
        *(v4u*)(Ks + skey * KV_PITCH + soct * 8) = kreg;
        Vt[(soct * 8 + 0) * KV_PITCH + skey] = (bf16)(vreg.x & 0xffff); Vt[(soct * 8 + 1) * KV_PITCH + skey] = (bf16)(vreg.x >> 16); Vt[(soct * 8 + 2) * KV_PITCH + skey] = (bf16)(vreg.y & 0xffff); Vt[(soct * 8 + 3) * KV_PITCH + skey] = (bf16)(vreg.y >> 16);
        Vt[(soct * 8 + 4) * KV_PITCH + skey] = (bf16)(vreg.z & 0xffff); Vt[(soct * 8 + 5) * KV_PITCH + skey] = (bf16)(vreg.z >> 16); Vt[(soct * 8 + 6) * KV_PITCH + skey] = (bf16)(vreg.w & 0xffff); Vt[(soct * 8 + 7) * KV_PITCH + skey] = (bf16)(vreg.w >> 16); }
    __syncthreads();
    for (int i = 0; i < nb; ++i) {
        const int J = bl[i];
        if (i + 1 < nb) { const int Jn = bl[i + 1]; const bf16* src = Zb + (size_t)(Jn * 64 + skey) * ZP + soct * 8; kreg = *(const v4u*)(src + kcol); vreg = *(const v4u*)(src + vcol); }
        const bf16* Ks = (const bf16*)(C.lds + A_KV + (i & 1) * KVBUF_BYTES); const bf16* Vt = Ks + 64 * KV_PITCH;
        int lo[2], hi[2]; const int rel = qb - J;
#pragma unroll
        for (int s = 0; s < 2; ++s) { const int qo = th * 32 + s * 16 + c16;
            if (type == 0) { lo[s] = (rel == 8) ? qo + 1 : 0; hi[s] = (rel == 0) ? qo : 63; }
            else { const bool sel = (sm[s] >> J) & 1u; lo[s] = sel ? 0 : 200; hi[s] = sel ? ((rel == 0) ? qo : 63) : -200; }
            lo[s] -= 4 * g; hi[s] -= 4 * g; }
        attn_block(Ks, Vt, qf, O, mrun, lrun, lo, hi, c16, g);
        if (i + 1 < nb) { bf16* Kn = (bf16*)(C.lds + A_KV + ((i + 1) & 1) * KVBUF_BYTES); bf16* Vn = Kn + 64 * KV_PITCH;
            *(v4u*)(Kn + skey * KV_PITCH + soct * 8) = kreg;
            Vn[(soct * 8 + 0) * KV_PITCH + skey] = (bf16)(vreg.x & 0xffff); Vn[(soct * 8 + 1) * KV_PITCH + skey] = (bf16)(vreg.x >> 16); Vn[(soct * 8 + 2) * KV_PITCH + skey] = (bf16)(vreg.y & 0xffff); Vn[(soct * 8 + 3) * KV_PITCH + skey] = (bf16)(vreg.y >> 16);
            Vn[(soct * 8 + 4) * KV_PITCH + skey] = (bf16)(vreg.z & 0xffff); Vn[(soct * 8 + 5) * KV_PITCH + skey] = (bf16)(vreg.z >> 16); Vn[(soct * 8 + 6) * KV_PITCH + skey] = (bf16)(vreg.w & 0xffff); Vn[(soct * 8 + 7) * KV_PITCH + skey] = (bf16)(vreg.w >> 16); }
        __syncthreads();
    }
#pragma unroll
    for (int s = 0; s < 2; ++s) { const float f = lrun[s] > 0.f ? gate[s] / lrun[s] : 0.f;
#pragma unroll
        for (int dt = 0; dt < 4; ++dt) out[s][dt] = out[s][dt] + O[s][dt] * f; }
}

__device__ __forceinline__ void nsa_unit(const Ctx& C, int u) {
    const int b = u >> 5, qb = u & 31, t0 = qb * 64, tid = opaque(C.tid), lane = tid & 63, w = __builtin_amdgcn_readfirstlane(tid >> 6);
    const int h = w >> 1, th = w & 1, c16 = lane & 15, g = lane >> 4;
    const bf16* Zb = (const bf16*)(C.ws + WS_Z) + (size_t)b * SEQ * ZP;
    unsigned char* lds = C.lds;
    { const bf16* kc = (const bf16*)(C.ws + WS_KCMP) + (size_t)b * 128 * 64; const bf16* vc = (const bf16*)(C.ws + WS_VCMP) + (size_t)b * 128 * 64;
      bf16* Kc = (bf16*)(lds + A_KC); bf16* Vct = (bf16*)(lds + A_VCT);
#pragma unroll
      for (int q = 0; q < 2; ++q) { const int idx = opaque(tid) + 512 * q, key = idx >> 3, oct = idx & 7;
          const v4u kr = *(const v4u*)(kc + key * 64 + oct * 8), vr = *(const v4u*)(vc + key * 64 + oct * 8);
          *(v4u*)(Kc + key * KV_PITCH + oct * 8) = kr;
          Vct[(oct * 8 + 0) * VCT_PITCH + key] = (bf16)(vr.x & 0xffff); Vct[(oct * 8 + 1) * VCT_PITCH + key] = (bf16)(vr.x >> 16); Vct[(oct * 8 + 2) * VCT_PITCH + key] = (bf16)(vr.y & 0xffff); Vct[(oct * 8 + 3) * VCT_PITCH + key] = (bf16)(vr.y >> 16);
          Vct[(oct * 8 + 4) * VCT_PITCH + key] = (bf16)(vr.z & 0xffff); Vct[(oct * 8 + 5) * VCT_PITCH + key] = (bf16)(vr.z >> 16); Vct[(oct * 8 + 6) * VCT_PITCH + key] = (bf16)(vr.w & 0xffff); Vct[(oct * 8 + 7) * VCT_PITCH + key] = (bf16)(vr.w >> 16); }
      if (tid < 64) ((unsigned*)(lds + A_SEL))[tid] = 0u;
      const int jw0 = qb >= 8 ? qb - 8 : 0; if (tid < 16) ((int*)(lds + A_BL))[tid] = jw0 + tid; }
    bf16x8 qf[2][2]; float gt[2][3];
#pragma unroll
    for (int s = 0; s < 2; ++s) { const bf16* qrow = Zb + (size_t)(t0 + th * 32 + s * 16 + c16) * ZP;
        qf[s][0] = *(const bf16x8*)(qrow + ZC_Q + h * 64 + g * 8); qf[s][1] = *(const bf16x8*)(qrow + ZC_Q + h * 64 + 32 + g * 8);
#pragma unroll
        for (int br = 0; br < 3; ++br) { const unsigned short raw = qrow[ZC_G + h * 3 + br]; gt[s][br] = sigmoidf_(bflo((unsigned)raw)); } }
    f32x4 out[2][4];
#pragma unroll
    for (int s = 0; s < 2; ++s)
#pragma unroll
        for (int dt = 0; dt < 4; ++dt) out[s][dt] = (f32x4){0.f, 0.f, 0.f, 0.f};
    __syncthreads();
    { const bf16* Kc = (const bf16*)(lds + A_KC); const bf16* Vct = (const bf16*)(lds + A_VCT); float* imp = (float*)(lds + A_IMP);
      const int nkt = ((4 * qb + 2) >> 4) + 1;
      f32x4 sc[2][8];
#pragma unroll
      for (int kt = 0; kt < 8; ++kt) {
#pragma unroll
          for (int s = 0; s < 2; ++s) sc[s][kt] = (f32x4){0.f, 0.f, 0.f, 0.f};
          if (kt < nkt) { const bf16x8 k0 = *(const bf16x8*)(Kc + (kt * 16 + c16) * KV_PITCH + g * 8), k1 = *(const bf16x8*)(Kc + (kt * 16 + c16) * KV_PITCH + 32 + g * 8);
#pragma unroll
              for (int s = 0; s < 2; ++s) { sc[s][kt] = MFMA16(k0, qf[s][0], sc[s][kt]); sc[s][kt] = MFMA16(k1, qf[s][1], sc[s][kt]); } } }
#pragma unroll
      for (int s = 0; s < 2; ++s) { const int t = t0 + th * 32 + s * 16 + c16; const int nrel = ((t >= 31) ? ((t - 31) >> 4) : -1) - 4 * g;
          float mx = NEG_BIG;
#pragma unroll
          for (int kt = 0; kt < 8; ++kt)
#pragma unroll
              for (int j = 0; j < 4; ++j) { const float v = (kt * 16 + j <= nrel) ? sc[s][kt][j] * SM_C : NEG_BIG; sc[s][kt][j] = v; mx = fmaxf(mx, v); }
          mx = fmaxf(mx, __shfl_xor(mx, 16)); mx = fmaxf(mx, __shfl_xor(mx, 32));
          float ps = 0.f;
#pragma unroll
          for (int kt = 0; kt < 8; ++kt)
#pragma unroll
              for (int j = 0; j < 4; ++j) { const float v = sc[s][kt][j]; const float p = (v > -1.0e29f) ? exp2f(v - mx) : 0.f; sc[s][kt][j] = p; ps += p; }
          ps += __shfl_xor(ps, 16); ps += __shfl_xor(ps, 32);
          const float inv = ps > 0.f ? 1.0f / ps : 0.f;
#pragma unroll
          for (int kt = 0; kt < 8; ++kt) sc[s][kt] = sc[s][kt] * inv;
          float* irow = imp + (h * 64 + th * 32 + s * 16 + c16) * 33;
          float cprev = 0.f;
#pragma unroll
          for (int kt = 0; kt < 8; ++kt) { const f32x4 p = sc[s][kt]; const float a = 2.f * (p[0] + p[1] + p[2]) + p[3];
              const float up = __shfl(p[3], (lane + 48) & 63);
              const float pv = (g > 0) ? up : cprev; cprev = up;
              irow[kt * 4 + g] = a + pv; }
      }
      f32x4 O[2][4];
#pragma unroll
      for (int s = 0; s < 2; ++s)
#pragma unroll
          for (int dt = 0; dt < 4; ++dt) O[s][dt] = (f32x4){0.f, 0.f, 0.f, 0.f};
#pragma unroll
      for (int kk = 0; kk < 4; ++kk) if (2 * kk < nkt) { bf16x8 pf[2];
#pragma unroll
          for (int s = 0; s < 2; ++s) { const f32x4 a = sc[s][2 * kk], bq = sc[s][2 * kk + 1]; v4u t; t.x = pk2(a[0], a[1]); t.y = pk2(a[2], a[3]); t.z = pk2(bq[0], bq[1]); t.w = pk2(bq[2], bq[3]); pf[s] = __builtin_bit_cast(bf16x8, t); }
#pragma unroll
          for (int dt = 0; dt < 4; ++dt) { const bf16* vp = Vct + (dt * 16 + c16) * VCT_PITCH + (2 * kk) * 16 + g * 4; const v2u v0 = *(const v2u*)vp, v1 = *(const v2u*)(vp + 16);
              v4u t; t.x = v0.x; t.y = v0.y; t.z = v1.x; t.w = v1.y; const bf16x8 vf = __builtin_bit_cast(bf16x8, t);
#pragma unroll
              for (int s = 0; s < 2; ++s) O[s][dt] = MFMA16(vf, pf[s], O[s][dt]); } }
#pragma unroll
      for (int s = 0; s < 2; ++s)
#pragma unroll
          for (int dt = 0; dt < 4; ++dt) out[s][dt] = O[s][dt] * gt[s][0];
    }
    __syncthreads();
    { const float* imp = (const float*)(lds + A_IMP); float* val = (float*)(lds + A_VAL);
#pragma unroll
      for (int q = 0; q < 4; ++q) { const int idx = opaque(tid) + 512 * q, tok = idx >> 5, J = idx & 31; const int back = qb - J;
          float v = ((imp[(0 * 64 + tok) * 33 + J] + imp[(1 * 64 + tok) * 33 + J]) + imp[(2 * 64 + tok) * 33 + J]) + imp[(3 * 64 + tok) * 33 + J];
          if (J == 0 || (back >= 0 && back < 2)) v = 1.0e9f; else if (back < 0) v = -1.0f;
          val[tok * 33 + J] = v; } }
    __syncthreads();
    { const float* val = (const float*)(lds + A_VAL); unsigned* selm = (unsigned*)(lds + A_SEL);
#pragma unroll
      for (int q = 0; q < 4; ++q) { const int idx = opaque(tid) + 512 * q, tok = idx >> 5, J = idx & 31; const float v = val[tok * 33 + J]; int rank = 0;
          for (int j2 = 0; j2 < 32; ++j2) { const float o = val[tok * 33 + j2]; rank += (o > v || (o == v && j2 < J)) ? 1 : 0; }
          if (J <= qb && rank < 8) atomicOr(&selm[tok], 1u << J); } }
    __syncthreads();
    { const int nwin = qb >= 8 ? 9 : qb + 1; float gate[2] = {gt[0][2], gt[1][2]};
      attn_branch(C, Zb, 0, nwin, qb, qf, gate, out, th); }
    { const unsigned* selm = (const unsigned*)(lds + A_SEL); unsigned um = selm[lane];
#pragma unroll
      for (int o = 1; o < 64; o <<= 1) um |= (unsigned)__shfl_xor((int)um, o);
      um = (unsigned)__builtin_amdgcn_readfirstlane((int)um);
      const int nslc = __builtin_popcount(um);
      if (tid == 0) { int* bl = (int*)(lds + A_BL); unsigned r = um; int k = 0; while (r) { const int J = __builtin_ctz(r); r &= r - 1; bl[k++] = J; } }
      __syncthreads();
      float gate[2] = {gt[0][1], gt[1][1]};
      attn_branch(C, Zb, 1, nslc, qb, qf, gate, out, th); }
    { bf16* MIX = (bf16*)(C.ws + WS_MIX); const int lz = opaque(lane), c16 = lz & 15, g = lz >> 4;
#pragma unroll
      for (int s = 0; s < 2; ++s) { bf16* orow = MIX + (size_t)(b * SEQ + t0 + th * 32 + s * 16 + c16) * DM + MC_NSA + h * 64;
#pragma unroll
          for (int dt = 0; dt < 4; ++dt) { const f32x4 o = out[s][dt]; v2u wv; wv.x = pk2(o[0], o[1]); wv.y = pk2(o[2], o[3]); *(v2u*)(orow + dt * 16 + g * 4) = wv; } } }
    __syncthreads();
}

constexpr int N_PHASES = 1 + DEPTH * 8;
__global__ void __launch_bounds__(NTHR, 2) hybrid_fwd(Args args) {
    extern __shared__ __attribute__((aligned(16))) unsigned char lds[];
    Ctx C; C.lds = lds; C.ws = ARGS.ws; C.tid = threadIdx.x; C.lane = C.tid & 63; C.wave = __builtin_amdgcn_readfirstlane(C.tid >> 6); C.G = gridDim.x; C.bid = blockIdx.x;
    const int lo = ARGS.ph_lo, hi = ARGS.ph_hi;
    int ph = 0;
#define IN(k) (lo <= (k) && (k) < hi)
#define SEAM(k) do { if (IN(k) && IN((k) + 1)) { cg::this_grid().sync(); } } while (0)

#ifndef NO_P0
    if (IN(0)) { const Ctx Cp = fresh(C); p0_prologue(Cp, ARGS); }
#endif

    SEAM(0);
    _Pragma("unroll") for (int l = 0; l < DEPTH; ++l) {
        ph = 1 + l * 8;

        if (IN(ph)) { const Ctx Cp = fresh(C); unsigned char* ws = Cp.ws; pg8::Gemm g{(const pg8::bf16_t*)(ws + WS_XNB), (const pg8::bf16_t*)(ws + WS_WIN) + (size_t)l * ZP * DM, M, ZP, DM}; pg8::StaticOrder S; S.init(M, ZP, Cp.G, Cp.bid);
            pg8::EpiBf16<0> E{(pg8::bf16_t*)(ws + WS_Z), ZP};
            pg8::gemm_phase<pg8::EpiBf16<0>, pg8::StaticOrder, true, true>((LAS unsigned char*)lds, g, S, E); }
        SEAM(ph); ++ph;
        if (IN(ph)) {
            const Ctx Cp = fresh(C);
#ifndef NO_CONV
            for (int u = Cp.bid; u < 256; u += Cp.G) conv_unit(Cp, ARGS, l, u);
#endif


#ifndef NO_POOL
            for (int u = Cp.bid; u < 256; u += Cp.G) pool_unit(Cp, ARGS, l, u);
#endif


#ifndef NO_SGU
            for (int u = Cp.bid; u < 256; u += Cp.G) sgu_unit(Cp, ARGS, l, u);
#endif


#ifndef NO_CMP
            for (int u = Cp.G - 1 - Cp.bid; u < 128; u += Cp.G) cmp_unit(Cp, ARGS, l, u);
#endif


#ifndef NO_ROPE
            rope_pass(Cp);
#endif

        }
        SEAM(ph); ++ph;

#ifndef NO_NSA
        if (IN(ph)) { const Ctx Cp = fresh(C); for (int u = Cp.G - 1 - Cp.bid; u >= 0 && u < 256; u += Cp.G) nsa_unit(Cp, u); }
#endif

        SEAM(ph); ++ph;
        if (IN(ph)) { const Ctx Cp = fresh(C); unsigned char* ws = Cp.ws; pg8::Gemm g{(const pg8::bf16_t*)(ws + WS_MIX), (const pg8::bf16_t*)(ws + WS_WOUT) + (size_t)l * DM * DM, M, DM, DM}; pg8::StaticOrder S; S.init(M, DM, Cp.G, Cp.bid);
            pg8::EpiF32 E{(float*)(ws + WS_Y1), DM};
            pg8::gemm_phase<pg8::EpiF32, pg8::StaticOrder, true, true>((LAS unsigned char*)lds, g, S, E); }
        SEAM(ph); ++ph;
        if (IN(ph)) { CA& A = ARGS; const Ctx Cp = fresh(C); norm_phase(Cp, (const float*)(Cp.ws + WS_Y1), (l == 0) ? (const float*)A.in[0] : (const float*)A.out, A.out, (const float*)A.in[3] + l * DM, (const float*)A.in[4] + l * DM, (bf16*)(Cp.ws + WS_XNA)); }
        SEAM(ph); ++ph;
        if (IN(ph)) { const Ctx Cp = fresh(C); unsigned char* ws = Cp.ws; pg8::Gemm g{(const pg8::bf16_t*)(ws + WS_XNA), (const pg8::bf16_t*)(ws + WS_W1) + (size_t)l * FF * DM, M, FF, DM}; pg8::StaticOrder S; S.init(M, FF, Cp.G, Cp.bid);
            pg8::EpiBf16<2> E{(pg8::bf16_t*)(ws + WS_F), FF};
            pg8::gemm_phase<pg8::EpiBf16<2>, pg8::StaticOrder, true, true>((LAS unsigned char*)lds, g, S, E); }
        SEAM(ph); ++ph;
        if (IN(ph)) { const Ctx Cp = fresh(C); unsigned char* ws = Cp.ws; pg8::Gemm g{(const pg8::bf16_t*)(ws + WS_F), (const pg8::bf16_t*)(ws + WS_W2) + (size_t)l * DM * FF, M, DM, FF}; pg8::StaticOrder S; S.init(M, DM, Cp.G, Cp.bid);
            pg8::EpiF32 E{(float*)(ws + WS_Y2), DM};
            pg8::gemm_phase<pg8::EpiF32, pg8::StaticOrder, true, true>((LAS unsigned char*)lds, g, S, E); }
        SEAM(ph); ++ph;
        if (IN(ph)) { CA& A = ARGS; const Ctx Cp = fresh(C); norm_phase(Cp, (const float*)(Cp.ws + WS_Y2), A.out, A.out, (const float*)A.in[5] + l * DM, (l + 1 < DEPTH) ? (const float*)A.in[2] + (l + 1) * DM : nullptr, (bf16*)(Cp.ws + WS_XNB)); }
        if (l + 1 < DEPTH) SEAM(ph);
    }
#undef IN
#undef SEAM
}

#ifndef MK_MULTI
#define MK_MULTI 0
#endif
extern "C" void kernel_launch(void* const* d_in, const int* in_sizes, int n_in, void* d_out, int out_size, void* d_ws, size_t ws_size, hipStream_t stream) {
    static int grid = 0;
    if (grid == 0) {
        if (n_in != 26 || out_size != M * DM || ws_size < WS_END) { fprintf(stderr, "kernel_launch: unexpected problem (n_in %d, out %d, ws %zu)\n", n_in, out_size, ws_size); grid = -1; return; }
        int dev = 0, cus = 0, per_cu = 0;
        hipGetDevice(&dev); hipDeviceGetAttribute(&cus, hipDeviceAttributeMultiprocessorCount, dev);
        if (hipFuncSetAttribute((const void*)hybrid_fwd, hipFuncAttributeMaxDynamicSharedMemorySize, LDS_BYTES) != hipSuccess) { fprintf(stderr, "kernel_launch: hipFuncSetAttribute failed\n"); grid = -1; return; }
        if (hipOccupancyMaxActiveBlocksPerMultiprocessor(&per_cu, (const void*)hybrid_fwd, NTHR, LDS_BYTES) != hipSuccess || per_cu < 1) { fprintf(stderr, "kernel_launch: occupancy query says %d\n", per_cu); per_cu = 1; }
        (void)hipGetLastError();
        grid = cus * per_cu;
        fprintf(stderr, "kernel_launch: grid %d (cus %d x %d)\n", grid, cus, per_cu);
    }
    if (grid < 0) return;
    Args a{};
    for (int i = 0; i < 26; ++i) a.in[i] = d_in[i];
    a.out = (float*)d_out; a.ws = (unsigned char*)d_ws;
#if MK_MULTI
    for (int p = 0; p < N_PHASES; ++p) { a.ph_lo = p; a.ph_hi = p + 1; hipLaunchKernelGGL(hybrid_fwd, dim3(grid), dim3(NTHR), LDS_BYTES, stream, a); }
#else
    a.ph_lo = 0; a.ph_hi = N_PHASES;
    void* kargs[] = {&a};
    hipError_t e = hipLaunchCooperativeKernel((const void*)hybrid_fwd, dim3(grid), dim3(NTHR), kargs, LDS_BYTES, stream);
    if (e != hipSuccess) fprintf(stderr, "kernel_launch: cooperative launch failed: %s (grid %d)\n", hipGetErrorString(e), grid);
#endif
}
```

```cpp
#include <hip/hip_runtime.h>
#include <hip/hip_cooperative_groups.h>
#include <cstdio>
#include <cstdint>
namespace cg = cooperative_groups;
namespace pg8 {
#define PG8_LAS __attribute__((address_space(3)))
typedef unsigned short bf16_t;
typedef short bf16x8 __attribute__((ext_vector_type(8)));
typedef float f32x4 __attribute__((ext_vector_type(4)));
typedef unsigned u32x4 __attribute__((ext_vector_type(4)));
constexpr int BM = 256, BK = 64, HALF = 128, HTB = HALF * BK * 2  , STAGE_BYTES = 8 * HTB, NXCD = 8, WGM = 8;

__host__ __device__ __forceinline__ int lds_byte(int r, int c) { const int st = (r >> 4) * 2 + (c >> 5), rr = r & 15, cc = c & 31, ob = rr * 64 + cc * 2; return st * 1024 + (ob ^ (((ob >> 9) & 1) << 5)); }
__host__ __device__ __forceinline__ void stage_rc(int b, int& R, int& C) { const int st = b / 1024, sb = b % 1024, swz = sb ^ (((sb >> 9) & 1) << 5); R = (st >> 1) * 16 + swz / 64; C = (st & 1) * 32 + (swz % 64) / 2; }
__host__ __device__ __forceinline__ int perm32(int rho) { const int n = rho >> 4, i = rho & 15; return 8 * (i >> 2) + 4 * n + (i & 3); }

struct Unit { int pm, pn; };
struct Gemm { const bf16_t* A; const bf16_t* Bt; int M, N, K; };

struct StaticOrder {
    int nM, nN, nwg, G, c;
    __host__ __device__ void init(int M, int N, int G_, int c_) { nM = M / BM; nN = N / BM; nwg = nM * nN; G = G_; c = c_; }
    __host__ __device__ bool next(int i, Unit& u) const {
        const long L = (long)i * G + c; if (L >= nwg) return false;
        int wgid = (int)L; { const int q = nwg / NXCD, r = nwg % NXCD, xcd = wgid % NXCD, off = wgid / NXCD; wgid = (xcd < r ? xcd * (q + 1) : r * (q + 1) + (xcd - r) * q) + off; }
        const int nig = WGM * nN, gid = wgid / nig, fm = gid * WGM, gsz = (nM - fm) < WGM ? (nM - fm) : WGM;
        u.pm = fm + ((wgid % nig) % gsz); u.pn = (wgid % nig) / gsz; return true;
    }
    __device__ __forceinline__ void a_ready(const Unit&) const {}
    __device__ __forceinline__ void done(const Unit&) const {}
};

__device__ __forceinline__ unsigned cvt_pk_bf16(float lo, float hi) { unsigned r; asm volatile("v_cvt_pk_bf16_f32 %0, %1, %2" : "=v"(r) : "v"(lo), "v"(hi)); return r; }
typedef float f32x2 __attribute__((ext_vector_type(2)));
template <int ACT  > struct EpiBf16 {
    static constexpr bool PERM = true, AFTER_DRAIN = false;
    bf16_t* O; int ldc;
    __device__ __forceinline__ void operator()(const f32x4 (&acc)[2][2][4][2], const Unit& u, int wr, int wc, int fr, int fq) const {
        const int row0 = u.pm * BM + wr * 64 + fr; const int col0 = u.pn * BM + wc * 32 + 8 * fq;
#pragma unroll
        for (int ai = 0; ai < 2; ++ai)
#pragma unroll
            for (int m = 0; m < 4; ++m) { bf16_t* rowp = O + (size_t)(row0 + ai * HALF + m * 16) * ldc + col0;
#pragma unroll
                for (int bj = 0; bj < 2; ++bj) { f32x4 v0 = acc[ai][bj][m][0], v1 = acc[ai][bj][m][1];
                    if (ACT == 2) {
#pragma unroll
                        for (int j = 0; j < 4; ++j) { const float a = v0[j] > 0.f ? v0[j] : 0.f, b = v1[j] > 0.f ? v1[j] : 0.f; v0[j] = a * a; v1[j] = b * b; } }
                    u32x4 w; w.x = cvt_pk_bf16(v0[0], v0[1]); w.y = cvt_pk_bf16(v0[2], v0[3]); w.z = cvt_pk_bf16(v1[0], v1[1]); w.w = cvt_pk_bf16(v1[2], v1[3]);
                    *(u32x4*)(rowp + bj * HALF) = w; } }
    }
};
struct EpiF32 {
    static constexpr bool PERM = false, AFTER_DRAIN = false;
    float* O; int ldc;
    __device__ __forceinline__ void operator()(const f32x4 (&acc)[2][2][4][2], const Unit& u, int wr, int wc, int fr, int fq) const {
        const int row0 = u.pm * BM + wr * 64 + fr; const int col0 = u.pn * BM + wc * 32 + 4 * fq;
#pragma unroll
        for (int ai = 0; ai < 2; ++ai)
#pragma unroll
            for (int m = 0; m < 4; ++m) { float* rowp = O + (size_t)(row0 + ai * HALF + m * 16) * ldc + col0;
#pragma unroll
                for (int bj = 0; bj < 2; ++bj)
#pragma unroll
                    for (int n = 0; n < 2; ++n) *(f32x4*)(rowp + bj * HALF + n * 16) = acc[ai][bj][m][n]; }
    }
};
template <class Epi, class Sched, bool ALIGN_EPI = false, bool SP2 = false>
__device__ __forceinline__ void gemm_phase(PG8_LAS unsigned char* lds, const Gemm g, const Sched& S, const Epi& E) {
    int tid_ = threadIdx.x; asm volatile("" : "+v"(tid_)); const int tid = tid_, wid = __builtin_amdgcn_readfirstlane(tid >> 6), lane = tid & 63, wr = wid >> 2, wc = wid & 3, fr = lane & 15, fq = lane >> 4;
    const int K = g.K, nt = K / BK;
    unsigned voffA[2], voffB[2];
#pragma unroll
    for (int i = 0; i < 2; ++i) { int R, C; stage_rc(tid * 16 + i * 8192, R, C); const int Rb = Epi::PERM ? ((R & ~31) + perm32(R & 31)) : R;
        voffA[i] = (unsigned)(R * K + C) * 2u; voffB[i] = (unsigned)(Rb * K + C) * 2u; }
    const size_t kstep = (size_t)(BK * 2);
    const size_t hstep = (size_t)HALF * K * 2;
    const size_t tstep = 2 * hstep;
    const unsigned ldsw = (unsigned)wid * 1024u;
    const int aoff = lds_byte(wr * 64 + fr, fq * 8), boff = lds_byte(wc * 32 + fr, fq * 8);
#define PG8_SA(b, h) (((b) * 2 + (h)) * HTB)
#define PG8_SB(b, h) ((4 + (b) * 2 + (h)) * HTB)
#define PG8_STAGE(bufoff, gbase, voff) do { _Pragma("unroll") for (int _i = 0; _i < 2; ++_i) \
        __builtin_amdgcn_global_load_lds((const unsigned*)((const char*)(gbase) + (voff)[_i]), (PG8_LAS unsigned*)(lds + (bufoff) + ldsw + _i * 8192), 16, 0, 0); } while (0)
#define PG8_LDA(dst, b, h) do { _Pragma("unroll") for (int m = 0; m < 4; ++m) _Pragma("unroll") for (int k = 0; k < 2; ++k) dst[m][k] = *(const PG8_LAS bf16x8*)(lds + PG8_SA(b, h) + aoff + m * 2048 + k * 1024); } while (0)
#define PG8_LDB(dst, b, h) do { _Pragma("unroll") for (int n = 0; n < 2; ++n) _Pragma("unroll") for (int k = 0; k < 2; ++k) dst[n][k] = *(const PG8_LAS bf16x8*)(lds + PG8_SB(b, h) + boff + n * 2048 + k * 1024); } while (0)
#define PG8_MMA(ai, bj, At, Bt) do { __builtin_amdgcn_s_setprio(1); _Pragma("unroll") for (int m = 0; m < 4; ++m) _Pragma("unroll") for (int n = 0; n < 2; ++n) _Pragma("unroll") for (int k = 0; k < 2; ++k) \
        acc[ai][bj][m][n] = __builtin_amdgcn_mfma_f32_16x16x32_bf16(Bt[n][k], At[m][k], acc[ai][bj][m][n], 0, 0, 0); __builtin_amdgcn_s_setprio(0); } while (0)
#define PG8_WAIT_V(n) asm volatile("s_waitcnt vmcnt(" #n ")" ::: "memory")
#define PG8_WAIT_L(n) asm volatile("s_waitcnt lgkmcnt(" #n ")" ::: "memory")
#define PG8_BAR __builtin_amdgcn_s_barrier()
#define PG8_SCHED __builtin_amdgcn_sched_barrier(0)
    Unit cur, nxt; int ui = 0;
    if (!S.next(0, cur)) return;
    f32x4 acc[2][2][4][2];
#pragma unroll
    for (int a = 0; a < 2; ++a)
#pragma unroll
        for (int b = 0; b < 2; ++b)
#pragma unroll
            for (int m = 0; m < 4; ++m)
#pragma unroll
                for (int n = 0; n < 2; ++n) acc[a][b][m][n] = (f32x4){0.f, 0.f, 0.f, 0.f};
    bf16x8 At[4][2], B0[2][2], B1[2][2];
    const char* cA = (const char*)g.A + (size_t)cur.pm * tstep; const char* cB = (const char*)g.Bt + (size_t)cur.pn * tstep;
    S.a_ready(cur);
    if constexpr (SP2) {
        PG8_STAGE(PG8_SB(0, 0), cB, voffB); PG8_STAGE(PG8_SB(0, 1), cB + hstep, voffB); PG8_STAGE(PG8_SA(0, 0), cA, voffA); PG8_STAGE(PG8_SA(0, 1), cA + hstep, voffA);
        if (wr == 1) PG8_BAR;
        PG8_WAIT_V(2); PG8_BAR;
        PG8_STAGE(PG8_SB(1, 0), cB + kstep, voffB); PG8_STAGE(PG8_SA(1, 0), cA + kstep, voffA); PG8_STAGE(PG8_SB(1, 1), cB + hstep + kstep, voffB);
        PG8_WAIT_V(6); PG8_BAR;
    } else {
        PG8_STAGE(PG8_SB(0, 0), cB, voffB); PG8_STAGE(PG8_SA(0, 0), cA, voffA); PG8_STAGE(PG8_SB(0, 1), cB + hstep, voffB); PG8_STAGE(PG8_SA(0, 1), cA + hstep, voffA);
        if (wr == 1) PG8_BAR;
        PG8_WAIT_V(4); PG8_BAR;
        PG8_STAGE(PG8_SB(1, 0), cB + kstep, voffB); PG8_STAGE(PG8_SA(1, 0), cA + kstep, voffA); PG8_STAGE(PG8_SB(1, 1), cB + hstep + kstep, voffB);
        PG8_WAIT_V(6); PG8_BAR;
    }
    for (;;) {
        const bool has_next = S.next(ui + 1, nxt);
        const char* nA = has_next ? (const char*)g.A + (size_t)nxt.pm * tstep : cA; const char* nB = has_next ? (const char*)g.Bt + (size_t)nxt.pn * tstep : cB;
        for (int t = 0; t < nt; t += 2) {
            const bool last = (t == nt - 2);
            const char* a1 = cA + (size_t)(t + 1) * kstep;
            const char* a2 = last ? nA : cA + (size_t)(t + 2) * kstep; const char* b2 = last ? nB : cB + (size_t)(t + 2) * kstep;
            const char* a3 = a2 + kstep; const char* b3 = b2 + kstep;
            if (last && has_next) S.a_ready(nxt);
            if constexpr (SP2) {
            PG8_LDB(B0, 0, 0); PG8_LDB(B1, 0, 1); PG8_SCHED; PG8_LDA(At, 0, 0); PG8_STAGE(PG8_SA(1, 1), a1 + hstep, voffA);
            PG8_WAIT_V(8); PG8_WAIT_L(0); PG8_BAR; PG8_MMA(0, 0, At, B0); PG8_MMA(0, 1, At, B1); PG8_BAR; PG8_SCHED;
            PG8_LDA(At, 0, 1); PG8_STAGE(PG8_SB(0, 0), b2, voffB); PG8_STAGE(PG8_SB(0, 1), b2 + hstep, voffB); PG8_STAGE(PG8_SA(0, 0), a2, voffA);
            PG8_WAIT_V(8); PG8_WAIT_L(0); PG8_BAR; PG8_MMA(1, 0, At, B0); PG8_MMA(1, 1, At, B1); PG8_BAR; PG8_SCHED;
            PG8_LDB(B0, 1, 0); PG8_LDB(B1, 1, 1); PG8_SCHED; PG8_LDA(At, 1, 0); PG8_STAGE(PG8_SA(0, 1), a2 + hstep, voffA);
            PG8_WAIT_V(8); PG8_WAIT_L(0); PG8_BAR; PG8_MMA(0, 0, At, B0); PG8_MMA(0, 1, At, B1); PG8_BAR; PG8_SCHED;
            PG8_LDA(At, 1, 1); PG8_STAGE(PG8_SB(1, 0), b3, voffB); PG8_STAGE(PG8_SB(1, 1), b3 + hstep, voffB); PG8_STAGE(PG8_SA(1, 0), a3, voffA);
            PG8_WAIT_V(8); PG8_WAIT_L(0); PG8_BAR; PG8_MMA(1, 0, At, B0); PG8_MMA(1, 1, At, B1); PG8_BAR; PG8_SCHED;
            } else {
            PG8_LDB(B0, 0, 0); PG8_SCHED; PG8_LDA(At, 0, 0); PG8_STAGE(PG8_SA(1, 1), a1 + hstep, voffA);
            PG8_WAIT_L(8); PG8_BAR; PG8_WAIT_L(0); PG8_MMA(0, 0, At, B0); PG8_BAR; PG8_SCHED;
            PG8_LDB(B1, 0, 1); PG8_STAGE(PG8_SB(0, 0), b2, voffB);
            PG8_BAR; PG8_WAIT_L(0); PG8_MMA(0, 1, At, B1); PG8_BAR;
            PG8_LDA(At, 0, 1); PG8_STAGE(PG8_SA(0, 0), a2, voffA);
            PG8_BAR; PG8_WAIT_L(0); PG8_MMA(1, 0, At, B0); PG8_BAR; PG8_SCHED;
            PG8_STAGE(PG8_SB(0, 1), b2 + hstep, voffB);
            PG8_WAIT_V(6); PG8_BAR; PG8_MMA(1, 1, At, B1); PG8_BAR;
            PG8_LDB(B0, 1, 0); PG8_SCHED; PG8_LDA(At, 1, 0); PG8_STAGE(PG8_SA(0, 1), a2 + hstep, voffA);
            PG8_WAIT_L(8); PG8_BAR; PG8_WAIT_L(0); PG8_MMA(0, 0, At, B0); PG8_BAR; PG8_SCHED;
            PG8_LDB(B1, 1, 1); PG8_STAGE(PG8_SB(1, 0), b3, voffB);
            PG8_BAR; PG8_WAIT_L(0); PG8_MMA(0, 1, At, B1); PG8_BAR;
            PG8_LDA(At, 1, 1); PG8_STAGE(PG8_SA(1, 0), a3, voffA);
            PG8_BAR; PG8_WAIT_L(0); PG8_MMA(1, 0, At, B0); PG8_BAR; PG8_SCHED;
            PG8_STAGE(PG8_SB(1, 1), b3 + hstep, voffB);
            PG8_WAIT_V(6); PG8_BAR; PG8_MMA(1, 1, At, B1); PG8_BAR;
            }
        }
        if constexpr (ALIGN_EPI) { if (wr == 0) PG8_BAR; }
        if constexpr (!Epi::AFTER_DRAIN) { E(acc, cur, wr, wc, fr, fq); S.done(cur); }
        if (!has_next) break;
#pragma unroll
        for (int a = 0; a < 2; ++a)
#pragma unroll
            for (int b = 0; b < 2; ++b)
#pragma unroll
                for (int m = 0; m < 4; ++m)
#pragma unroll
                    for (int n = 0; n < 2; ++n) acc[a][b][m][n] = (f32x4){0.f, 0.f, 0.f, 0.f};
        cur = nxt; cA = nA; cB = nB; ++ui;
        if constexpr (ALIGN_EPI) { if (wr == 1) PG8_BAR; }
    }
    PG8_WAIT_V(0);
    if constexpr (!ALIGN_EPI) { if (wr == 0) PG8_BAR; }
    PG8_BAR;
    if constexpr (Epi::AFTER_DRAIN) { E.fused(acc, cur, wr, wc, fr, fq, lds, wid, lane); S.done(cur); }
#undef PG8_SA
#undef PG8_SB
#undef PG8_STAGE
#undef PG8_LDA
#undef PG8_LDB
#undef PG8_MMA
#undef PG8_WAIT_V
#undef PG8_WAIT_L
#undef PG8_BAR
#undef PG8_SCHED
}
}

constexpr int NWAVES = 8, NTHR = 512;
constexpr int BATCH = 8, SEQ = 2048, DM = 1024, DIN = 1932, ZP = 2048, FF = 4096, DEPTH = 2;
constexpr int M = BATCH * SEQ;
constexpr float NORM_EPS = 1e-6f;
constexpr int ZC_CVAL = 0, ZC_CGATE = 256, ZC_POOL = 512, ZC_SU = 768, ZC_SV = 1024, ZC_Q = 1280, ZC_KC = 1536, ZC_VC = 1600, ZC_KS = 1664, ZC_VS = 1728, ZC_KW = 1792, ZC_VW = 1856, ZC_G = 1920;
constexpr int MC_CONV = 0, MC_POOL = 256, MC_SGU = 512, MC_NSA = 768;
constexpr size_t MiB = 1u << 20, KiB = 1u << 10;
constexpr size_t WS_WIN = 1 * MiB, WS_WOUT = 9 * MiB, WS_W1 = 13 * MiB, WS_W2 = 29 * MiB, WS_CW1 = 45 * MiB;
constexpr size_t WS_SGUW = 46 * MiB, WS_POOLW = 46 * MiB + 256 * KiB, WS_C0 = 46 * MiB + 384 * KiB, WS_COS = 46 * MiB + 512 * KiB, WS_SIN = 47 * MiB;
constexpr size_t WS_KCMP = 47 * MiB + 512 * KiB, WS_VCMP = 47 * MiB + 640 * KiB;
constexpr size_t WS_XNA = 48 * MiB, WS_Y2 = 48 * MiB;
constexpr size_t WS_Z = 128 * MiB, WS_Y1 = 128 * MiB;
constexpr size_t WS_MIX = 192 * MiB, WS_XNB = 224 * MiB;
constexpr size_t WS_F = 128 * MiB, WS_END = 256 * MiB;
constexpr int LDS_BYTES = 147456;
constexpr int LDS_CTL_OFF = 131072;
constexpr size_t WS_BAR = 0, BAR_ZERO_BYTES = 16384;

typedef unsigned short bf16;
typedef unsigned v4u __attribute__((ext_vector_type(4)));
typedef unsigned v2u __attribute__((ext_vector_type(2)));
typedef float f32x4 __attribute__((ext_vector_type(4)));
typedef float f32x2 __attribute__((ext_vector_type(2)));
typedef short bf16x8 __attribute__((ext_vector_type(8)));
typedef short s16x4 __attribute__((ext_vector_type(4)));
#define LAS __attribute__((address_space(3)))
#define MFMA16(a, b, c) __builtin_amdgcn_mfma_f32_16x16x32_bf16((a), (b), (c), 0, 0, 0)

__device__ __forceinline__ unsigned f2bf(float f) { unsigned u = __builtin_bit_cast(unsigned, f); return (u + 0x7fffu + ((u >> 16) & 1u)) >> 16; }
__device__ __forceinline__ unsigned pk2(float lo, float hi) { return f2bf(lo) | (f2bf(hi) << 16); }
__device__ __forceinline__ float bflo(unsigned w) { return __builtin_bit_cast(float, w << 16); }
__device__ __forceinline__ float bfhi(unsigned w) { return __builtin_bit_cast(float, w & 0xffff0000u); }
__device__ __forceinline__ float wave_sum(float v) {
#pragma unroll
    for (int o = 1; o < 64; o <<= 1) v += __shfl_xor(v, o);
    return v;
}
__device__ __forceinline__ float sigmoidf_(float x) { return 1.0f / (1.0f + __expf(-x)); }
__device__ __forceinline__ float gelu_tanh(float x) {
    const float y = 0.7978845608028654f * (x + 0.044715f * x * x * x);
    const float t = 1.0f - 2.0f / (__expf(2.0f * y) + 1.0f);
    return 0.5f * x * (1.0f + t);
}

#define RLX_AGENT __ATOMIC_RELAXED, __HIP_MEMORY_SCOPE_AGENT
#define XB_TMO      128
#define XB_XCNT(j)  (256  + 64 * (j))
#define XB_XSUB(j)  (1280 + 64 * (j))
#define XB_XGEN(j)  (2304 + 64 * (j))
#define XB_TOP      3328
#define XB_TOPGEN   3392
#define XCD_BAR_WORDS 3456
#define XB_SPIN_CAP (1u << 18)

__device__ __forceinline__ unsigned xb_ld(unsigned* p)              { return __hip_atomic_load(p, __ATOMIC_RELAXED, __HIP_MEMORY_SCOPE_AGENT); }
__device__ __forceinline__ unsigned xb_add(unsigned* p, unsigned v) { return __hip_atomic_fetch_add(p, v, __ATOMIC_RELAXED, __HIP_MEMORY_SCOPE_AGENT); }
__device__ __forceinline__ unsigned xb_xcc_id() { return (unsigned)__builtin_amdgcn_s_getreg((3 << 11) | 20) & 0xFu; }
#define XB_SPIN(cond, bar) do { unsigned _sp = 0; while (cond) { __builtin_amdgcn_s_sleep(1); \
    if ((++_sp & 255u) == 0u) { if (xb_ld(&(bar)[XB_TMO])) break; if (_sp > XB_SPIN_CAP) { atomicAdd(&(bar)[XB_TMO], 1u); break; } } } } while (0)

struct XcdBarrier {
    unsigned* bar; unsigned x;
    volatile LAS unsigned* st;
};

__device__ __forceinline__ XcdBarrier xcd_barrier_post(unsigned* bar, volatile LAS unsigned* st) {
    XcdBarrier b; b.bar = bar; b.x = xb_xcc_id(); b.st = st;
    if (threadIdx.x == 0) (void)xb_add(&bar[XB_XCNT(b.x)], 1u);
    return b;
}
__device__ __forceinline__ void xcd_barrier_complete(unsigned* bar, unsigned x, unsigned& nloc, unsigned& nx) {
    const unsigned G = gridDim.x * gridDim.y * gridDim.z;
    unsigned sum, cnt, mine, sp = 0u;
    for (;;) {
        sum = 0u; cnt = 0u; mine = 0u;
#pragma unroll
        for (unsigned j = 0; j < 16; ++j) { const unsigned c = xb_ld(&bar[XB_XCNT(j)]); sum += c; cnt += (c > 0u) ? 1u : 0u; mine = (j == x) ? c : mine; }
        if (sum == G) break;
        __builtin_amdgcn_s_sleep(1);
        if ((++sp & 255u) == 0u) { if (xb_ld(&bar[XB_TMO])) break; if (sp > XB_SPIN_CAP) { atomicAdd(&bar[XB_TMO], 1u); break; } }
    }
    nloc = mine > 0u ? mine : 1u; nx = cnt > 0u ? cnt : 1u;
}

__device__ __forceinline__ void xcd_barrier(const XcdBarrier& b) {
    asm volatile("s_waitcnt vmcnt(0)" ::: "memory");
    __syncthreads();
    if (threadIdx.x == 0) {
        unsigned* bar = b.bar;
        __builtin_amdgcn_s_waitcnt(0);
        unsigned nloc = b.st[0], nx = b.st[1];
        if (nloc == 0u) { xcd_barrier_complete(bar, b.x, nloc, nx); b.st[0] = nloc; b.st[1] = nx; }
        const unsigned old = xb_add(&bar[XB_XSUB(b.x)], 1u);
        const unsigned gen = old / nloc;
        if (old + 1u == (gen + 1u) * nloc) {
            __builtin_amdgcn_fence(__ATOMIC_RELEASE, "agent");
            asm volatile("s_waitcnt vmcnt(0)" ::: "memory");
            const unsigned og = xb_add(&bar[XB_TOP], 1u);
            const unsigned tg = og / nx;
            if (og + 1u == (tg + 1u) * nx) xb_add(&bar[XB_TOPGEN], 1u);
            else XB_SPIN(xb_ld(&bar[XB_TOPGEN]) == tg, bar);
            __builtin_amdgcn_fence(__ATOMIC_ACQUIRE, "agent");
            xb_add(&bar[XB_XGEN(b.x)], 1u);
            asm volatile("s_waitcnt vmcnt(0)" ::: "memory");
        } else {
            XB_SPIN(xb_ld(&bar[XB_XGEN(b.x)]) == gen, bar);
            __builtin_amdgcn_fence(__ATOMIC_ACQUIRE, "agent");
            asm volatile("s_waitcnt vmcnt(0)" ::: "memory");
        }
    }
    __syncthreads();
}

struct Args { const void* in[26]; float* out; unsigned char* ws; int ph_lo, ph_hi; };
typedef const __attribute__((address_space(4))) Args CA;
__device__ __forceinline__ CA* get_args() { CA* p = (CA*)__builtin_amdgcn_kernarg_segment_ptr(); asm volatile("" : "+s"(p)); return p; }
#define ARGS (*get_args())

struct Ctx {
    unsigned char* lds; unsigned char* ws;
    int tid, lane, wave, G, bid;
};

__device__ __forceinline__ Ctx fresh(const Ctx& C0) { Ctx C = C0; int t = C0.tid; asm volatile("" : "+v"(t)); C.tid = t; C.lane = t & 63; C.wave = __builtin_amdgcn_readfirstlane(t >> 6); int b = C0.bid; asm volatile("" : "+s"(b)); C.bid = b; unsigned char* w = C0.ws; asm volatile("" : "+s"(w)); C.ws = w; return C; }
__device__ __forceinline__ void p0_transpose_item(const float* W, int K, int Nsrc, int Npad, bf16* WT, float* scr, int item, int lane) {
    const int nblk = Npad / 32, kb = item / nblk, nb = item % nblk, k0 = 64 * kb, n0 = 32 * nb;
    const int nn = n0 + (lane & 31);
#pragma unroll 8
    for (int i = 0; i < 32; ++i) { const int kk = 2 * i + (lane >> 5); scr[kk * 33 + (lane & 31)] = (nn < Nsrc) ? W[(size_t)(k0 + kk) * Nsrc + nn] : 0.f; }
    asm volatile("s_waitcnt lgkmcnt(0)" ::: "memory");
    const int c = lane & 7;
#pragma unroll
    for (int j = 0; j < 4; ++j) { const int n = (lane >> 3) + 8 * j; const float* s = scr + (8 * c) * 33 + n;
        v4u o; o.x = pk2(s[0 * 33], s[1 * 33]); o.y = pk2(s[2 * 33], s[3 * 33]); o.z = pk2(s[4 * 33], s[5 * 33]); o.w = pk2(s[6 * 33], s[7 * 33]);
        *(v4u*)(WT + (size_t)(n0 + n) * K + k0 + 8 * c) = o; }
    asm volatile("s_waitcnt lgkmcnt(0)" ::: "memory");
}
__device__ __forceinline__ void norm_row(const float* y, const float* xin, float* xout, const float* gpost, const float* gnext, bf16* xn, int lane) {
    f32x4 v[4];
#pragma unroll
    for (int j = 0; j < 4; ++j) v[j] = *((const f32x4*)xin + lane + 64 * j);
    if (y) {
        f32x4 yv[4]; float s = 0.f;
#pragma unroll
        for (int j = 0; j < 4; ++j) { yv[j] = *((const f32x4*)y + lane + 64 * j); s += (yv[j].x * yv[j].x + yv[j].y * yv[j].y) + (yv[j].z * yv[j].z + yv[j].w * yv[j].w); }
        const float r = 1.0f / sqrtf(wave_sum(s) * (1.f / DM) + NORM_EPS);
#pragma unroll
        for (int j = 0; j < 4; ++j) { const f32x4 g = *((const f32x4*)gpost + lane + 64 * j); v[j] = v[j] + yv[j] * r * g; *((f32x4*)xout + lane + 64 * j) = v[j]; }
    }
    if (gnext) {
        float s = 0.f;
#pragma unroll
        for (int j = 0; j < 4; ++j) s += (v[j].x * v[j].x + v[j].y * v[j].y) + (v[j].z * v[j].z + v[j].w * v[j].w);
        const float r = 1.0f / sqrtf(wave_sum(s) * (1.f / DM) + NORM_EPS);
#pragma unroll
        for (int j = 0; j < 4; ++j) { const f32x4 g = *((const f32x4*)gnext + lane + 64 * j); const f32x4 o = v[j] * r * g;
            v2u w; w.x = pk2(o.x, o.y); w.y = pk2(o.z, o.w); *((v2u*)xn + lane + 64 * j) = w; }
    }
}
__device__ __forceinline__ void norm_phase(const Ctx& C, const float* Y, const float* xin, float* xout, const float* gpost, const float* gnext, bf16* XN) {
    const int gw = C.bid * NWAVES + C.wave, NGW = C.G * NWAVES;
    for (int m = gw; m < M; m += NGW) norm_row(Y ? Y + (size_t)m * DM : nullptr, xin + (size_t)m * DM, xout ? xout + (size_t)m * DM : nullptr, gpost, gnext, XN + (size_t)m * DM, C.lane);
}

__device__ __forceinline__ void p0_prologue(const Ctx& C, CA& A) {
    float* scr = (float*)(C.lds + C.wave * 16384);
    unsigned char* ws = C.ws;
    const int gw = C.bid * NWAVES + C.wave, NGW = C.G * NWAVES;
    constexpr int I_IN = (DM / 64) * (ZP / 32), I_OUT = (DM / 64) * (DM / 32), I_1 = (DM / 64) * (FF / 32), I_2 = (FF / 64) * (DM / 32), I_CW = (2048 / 64) * (64 / 32), I_PW = 2;
    constexpr int PER_L = I_IN + I_OUT + I_1 + I_2 + 2 * I_CW + 4 * I_PW;
    for (int it = gw; it < DEPTH * PER_L; it += NGW) {
        const int l = it / PER_L; int r = it % PER_L;
        if (r < I_IN) { p0_transpose_item((const float*)A.in[6] + (size_t)l * DM * DIN, DM, DIN, ZP, (bf16*)(ws + WS_WIN) + (size_t)l * ZP * DM, scr, r, C.lane); continue; } r -= I_IN;
        if (r < I_OUT) { p0_transpose_item((const float*)A.in[23] + (size_t)l * DM * DM, DM, DM, DM, (bf16*)(ws + WS_WOUT) + (size_t)l * DM * DM, scr, r, C.lane); continue; } r -= I_OUT;
        if (r < I_1) { p0_transpose_item((const float*)A.in[24] + (size_t)l * DM * FF, DM, FF, FF, (bf16*)(ws + WS_W1) + (size_t)l * FF * DM, scr, r, C.lane); continue; } r -= I_1;
        if (r < I_2) { p0_transpose_item((const float*)A.in[25] + (size_t)l * FF * DM, FF, DM, DM, (bf16*)(ws + WS_W2) + (size_t)l * DM * FF, scr, r, C.lane); continue; } r -= I_2;
        if (r < 2 * I_CW) { const int kv = r / I_CW; p0_transpose_item((const float*)A.in[kv ? 21 : 18] + (size_t)l * 2048 * 64, 2048, 64, 64, (bf16*)(ws + WS_CW1) + (size_t)(l * 2 + kv) * 64 * 2048, scr, r % I_CW, C.lane); continue; } r -= 2 * I_CW;
        { const int gi = r / I_PW; p0_transpose_item((const float*)A.in[11] + (size_t)(l * 4 + gi) * 4096, 64, 64, 64, (bf16*)(ws + WS_POOLW) + (size_t)(l * 4 + gi) * 4096, scr, r % I_PW, C.lane); }
    }
    { const float* sw = (const float*)A.in[15]; bf16* dst = (bf16*)(ws + WS_SGUW);
      for (int i = C.bid * NTHR + C.tid; i < DEPTH * 4 * 128 * 128; i += C.G * NTHR) { const int s = i & 127, t = (i >> 7) & 127; dst[i] = (bf16)f2bf(s <= t ? sw[i] : 0.f); } }
    if (gw < DEPTH * 2 * 8) { const int l = gw >> 4, kv = (gw >> 3) & 1, eg = gw & 7; const float* pe = (const float*)A.in[kv ? 20 : 17] + (size_t)l * 2048; const float* w1 = (const float*)A.in[kv ? 21 : 18] + (size_t)l * 2048 * 64 + eg * 8;
        f32x4 a0 = (f32x4){0.f, 0.f, 0.f, 0.f}, a1 = (f32x4){0.f, 0.f, 0.f, 0.f};
#pragma unroll 8
        for (int i = 0; i < 32; ++i) { const int k = C.lane * 32 + i; const float p = pe[k]; a0 = a0 + *(const f32x4*)(w1 + (size_t)k * 64) * p; a1 = a1 + *(const f32x4*)(w1 + (size_t)k * 64 + 4) * p; }
        float r[8] = {a0.x, a0.y, a0.z, a0.w, a1.x, a1.y, a1.z, a1.w};
#pragma unroll
        for (int j = 0; j < 8; ++j) r[j] = wave_sum(r[j]);
        if (C.lane == 0) { float* dst = (float*)(ws + WS_C0) + (l * 2 + kv) * 64 + eg * 8;
#pragma unroll
            for (int j = 0; j < 8; ++j) dst[j] = r[j]; } }
    { const int* pos = (const int*)A.in[1]; float* ct = (float*)(ws + WS_COS); float* st = (float*)(ws + WS_SIN);
      for (int i = C.bid * NTHR + C.tid; i < M * 8; i += C.G * NTHR) { const int m = i >> 3, k = i & 7;
          const double inv = k == 0 ? 1.0 : k == 1 ? 0.19392274474868576 : k == 2 ? 0.03760603093086393 : k == 3 ? 0.007292664737217109 : k == 4 ? 0.001414213562373095 : k == 5 ? 0.0002742481756762073 : k == 6 ? 5.318295896944988e-05 : 1.031338537721246e-05;
          const double rev = (double)pos[m] * inv * 0.15915494309189535; const float fr = (float)(rev - floor(rev));
          ct[i] = __builtin_amdgcn_cosf(fr); st[i] = __builtin_amdgcn_sinf(fr); } }
    norm_phase(C, nullptr, (const float*)A.in[0], nullptr, nullptr, (const float*)A.in[2], (bf16*)(ws + WS_XNB));
}

__device__ __forceinline__ void unpack8(const v4u w, float* f) { f[0] = bflo(w.x); f[1] = bfhi(w.x); f[2] = bflo(w.y); f[3] = bfhi(w.y); f[4] = bflo(w.z); f[5] = bfhi(w.z); f[6] = bflo(w.w); f[7] = bfhi(w.w); }

__device__ __forceinline__ void conv_unit(const Ctx& C, CA& A, int l, int u) {
    const int b = u >> 5, t0 = (u & 31) * 64, tid = C.tid;
    float* hb = (float*)C.lds;
    const bf16* Z = (const bf16*)(C.ws + WS_Z) + (size_t)b * SEQ * ZP;
    for (int r = tid >> 5; r < 94; r += 16) {
        const int t = t0 - 30 + r, c8 = (tid & 31) * 8; float hv[8];
        if (t >= 0) { const v4u a = *(const v4u*)(Z + (size_t)t * ZP + ZC_CVAL + c8), gt = *(const v4u*)(Z + (size_t)t * ZP + ZC_CGATE + c8); float av[8], gv[8]; unpack8(a, av); unpack8(gt, gv);
#pragma unroll
            for (int j = 0; j < 8; ++j) hv[j] = av[j] * sigmoidf_(gv[j]); }
        else {
#pragma unroll
            for (int j = 0; j < 8; ++j) hv[j] = 0.f; }
        *(f32x4*)(hb + r * 256 + c8) = (f32x4){hv[0], hv[1], hv[2], hv[3]}; *(f32x4*)(hb + r * 256 + c8 + 4) = (f32x4){hv[4], hv[5], hv[6], hv[7]};
    }
    __syncthreads();
    const int c = tid & 255, base = (tid >> 8) * 32;
    const float* cw = (const float*)A.in[7] + (size_t)l * 31 * 256; const float bias = ((const float*)A.in[8])[l * 256 + c];
    float w[31];
#pragma unroll
    for (int k = 0; k < 31; ++k) w[k] = cw[k * 256 + c];
    float o[32];
#pragma unroll
    for (int ch = 0; ch < 4; ++ch) {
        float hv[38];
#pragma unroll
        for (int r = 0; r < 38; ++r) hv[r] = hb[(base + ch * 8 + r) * 256 + c];
#pragma unroll
        for (int i = 0; i < 8; ++i) { float acc = bias;
#pragma unroll
            for (int k = 0; k < 31; ++k) acc += w[k] * hv[i + k];
            o[ch * 8 + i] = acc; }
    }
    __syncthreads();
    float* ob = (float*)C.lds;
#pragma unroll
    for (int i = 0; i < 32; ++i) ob[(base + i) * 256 + c] = o[i];
    __syncthreads();
    const f32x4 g = *((const f32x4*)((const float*)A.in[9] + l * 256) + C.lane), bb = *((const f32x4*)((const float*)A.in[10] + l * 256) + C.lane);
    bf16* MIX = (bf16*)(C.ws + WS_MIX);
#pragma unroll 2
    for (int i = 0; i < 8; ++i) { const int tok = C.wave * 8 + i; f32x4 v = *((const f32x4*)(ob + tok * 256) + C.lane);
        const float mu = wave_sum((v.x + v.y) + (v.z + v.w)) * (1.f / 256.f); v = v - mu;
        const float var = wave_sum((v.x * v.x + v.y * v.y) + (v.z * v.z + v.w * v.w)) * (1.f / 256.f); const float rstd = 1.0f / sqrtf(var + NORM_EPS);
        f32x4 y = v * rstd * g + bb; y.x *= sigmoidf_(y.x); y.y *= sigmoidf_(y.y); y.z *= sigmoidf_(y.z); y.w *= sigmoidf_(y.w);
        v2u wv; wv.x = pk2(y.x, y.y); wv.y = pk2(y.z, y.w); *(v2u*)(MIX + (size_t)(b * SEQ + t0 + tok) * DM + MC_CONV + C.lane * 4) = wv; }
    __syncthreads();
}

__device__ __forceinline__ void pool_unit(const Ctx& C, CA& A, int l, int u) {
    const int b = u >> 5, t0 = (u & 31) * 64, tid = C.tid, lane = C.lane;
    float* pb = (float*)C.lds;
    bf16* mb = (bf16*)(C.lds + 81920);
    const bf16* Z = (const bf16*)(C.ws + WS_Z) + (size_t)b * SEQ * ZP;
    for (int r = tid >> 5; r < 79; r += 16) {
        const int t = t0 - 15 + r, c8 = (tid & 31) * 8; float hv[8];
        if (t >= 0) { const v4u a = *(const v4u*)(Z + (size_t)t * ZP + ZC_POOL + c8); unpack8(a, hv); }
        else {
#pragma unroll
            for (int j = 0; j < 8; ++j) hv[j] = 0.f; }
        *(f32x4*)(pb + r * 256 + c8) = (f32x4){hv[0], hv[1], hv[2], hv[3]}; *(f32x4*)(pb + r * 256 + c8 + 4) = (f32x4){hv[4], hv[5], hv[6], hv[7]};
    }
    __syncthreads();
    { const int c = tid & 255, base = (tid >> 8) * 32, gi = c >> 6, win = 2 << gi;
      float s = 0.f; for (int k = 0; k < win; ++k) s += pb[(base + 15 - k) * 256 + c];
      for (int i = 0; i < 32; ++i) { const int tok = base + i; const float cur = pb[(tok + 15) * 256 + c];
          if (i > 0) s += cur - pb[(tok + 15 - win) * 256 + c];
          const int t = t0 + tok; const int cnt = (t + 1 < win) ? (t + 1) : win;
          mb[tok * 264 + c] = (bf16)f2bf(s / (float)cnt - cur); } }
    __syncthreads();
    { const int gi = C.wave >> 1, mt0 = (C.wave & 1) * 2, c16 = lane & 15, g = lane >> 4;
      const bf16* wT = (const bf16*)(C.ws + WS_POOLW) + (size_t)(l * 4 + gi) * 4096;
      f32x4 acc[2][4];
#pragma unroll
      for (int mi = 0; mi < 2; ++mi)
#pragma unroll
          for (int nt = 0; nt < 4; ++nt) acc[mi][nt] = (f32x4){0.f, 0.f, 0.f, 0.f};
#pragma unroll
      for (int ks = 0; ks < 2; ++ks) { bf16x8 mf[2];
#pragma unroll
          for (int mi = 0; mi < 2; ++mi) mf[mi] = *(const bf16x8*)(mb + ((mt0 + mi) * 16 + c16) * 264 + gi * 64 + ks * 32 + g * 8);
#pragma unroll
          for (int nt = 0; nt < 4; ++nt) { const bf16x8 wf = *(const bf16x8*)(wT + (nt * 16 + c16) * 64 + ks * 32 + g * 8);
#pragma unroll
              for (int mi = 0; mi < 2; ++mi) acc[mi][nt] = MFMA16(wf, mf[mi], acc[mi][nt]); } }
      const float* ps = (const float*)A.in[12] + l * 256 + gi * 64; bf16* MIX = (bf16*)(C.ws + WS_MIX);
#pragma unroll
      for (int mi = 0; mi < 2; ++mi)
#pragma unroll
          for (int nt = 0; nt < 4; ++nt) { const int tok = (mt0 + mi) * 16 + c16, d = nt * 16 + g * 4; const f32x4 sc = *(const f32x4*)(ps + d); const f32x4 o = acc[mi][nt] * sc;
              v2u wv; wv.x = pk2(o.x, o.y); wv.y = pk2(o.z, o.w); *(v2u*)(MIX + (size_t)(b * SEQ + t0 + tok) * DM + MC_POOL + gi * 64 + d) = wv; } }
    __syncthreads();
}

__device__ __forceinline__ void sgu_unit(const Ctx& C, CA& A, int l, int u) {
    const int b = u >> 5, ck = (u & 31) >> 1, hp = u & 1, t0 = ck * 128, lane = C.lane, w = C.wave;
    bf16* vT = (bf16*)C.lds;
    const bf16* Z = (const bf16*)(C.ws + WS_Z) + (size_t)(b * SEQ + t0) * ZP;
    { const f32x4 g = *((const f32x4*)((const float*)A.in[13] + l * 256) + lane), bb = *((const f32x4*)((const float*)A.in[14] + l * 256) + lane);
#pragma unroll 2
      for (int i = 0; i < 16; ++i) { const int tok = w * 16 + i; const v2u raw = *(const v2u*)(Z + (size_t)tok * ZP + ZC_SV + lane * 4);
          f32x4 v = (f32x4){gelu_tanh(bflo(raw.x)), gelu_tanh(bfhi(raw.x)), gelu_tanh(bflo(raw.y)), gelu_tanh(bfhi(raw.y))};
          const float mu = wave_sum((v.x + v.y) + (v.z + v.w)) * (1.f / 256.f); v = v - mu;
          const float var = wave_sum((v.x * v.x + v.y * v.y) + (v.z * v.z + v.w * v.w)) * (1.f / 256.f); const float rstd = 1.0f / sqrtf(var + NORM_EPS);
          const f32x4 y = v * rstd * g + bb;
          if ((lane >> 5) == hp) { const int cl = (lane & 31) * 4; vT[(cl + 0) * 136 + tok] = (bf16)f2bf(y.x); vT[(cl + 1) * 136 + tok] = (bf16)f2bf(y.y); vT[(cl + 2) * 136 + tok] = (bf16)f2bf(y.z); vT[(cl + 3) * 136 + tok] = (bf16)f2bf(y.w); } } }
    __syncthreads();
    { const int c16 = lane & 15, g = lane >> 4, nks = ((16 * w + 15) >> 5) + 1, tok = w * 16 + c16;
      bf16* MIX = (bf16*)(C.ws + WS_MIX);
#pragma unroll
      for (int hh = 0; hh < 2; ++hh) { const int h = hp * 2 + hh; const bf16* Wh = (const bf16*)(C.ws + WS_SGUW) + (size_t)(l * 4 + h) * 128 * 128;
          f32x4 acc[4];
#pragma unroll
          for (int dt = 0; dt < 4; ++dt) acc[dt] = (f32x4){0.f, 0.f, 0.f, 0.f};
#pragma unroll
          for (int ks = 0; ks < 4; ++ks) if (ks < nks) { const bf16x8 wf = *(const bf16x8*)(Wh + (size_t)tok * 128 + ks * 32 + g * 8);
#pragma unroll
              for (int dt = 0; dt < 4; ++dt) { const bf16x8 vf = *(const bf16x8*)(vT + (hh * 64 + dt * 16 + c16) * 136 + ks * 32 + g * 8); acc[dt] = MFMA16(vf, wf, acc[dt]); } }
          const float bias = ((const float*)A.in[16])[(l * 4 + h) * 128 + tok];
#pragma unroll
          for (int dt = 0; dt < 4; ++dt) { const int d = dt * 16 + g * 4; const v2u raw = *(const v2u*)(Z + (size_t)tok * ZP + ZC_SU + h * 64 + d);
              const float o0 = gelu_tanh(bflo(raw.x)) * (acc[dt][0] + bias), o1 = gelu_tanh(bfhi(raw.x)) * (acc[dt][1] + bias), o2 = gelu_tanh(bflo(raw.y)) * (acc[dt][2] + bias), o3 = gelu_tanh(bfhi(raw.y)) * (acc[dt][3] + bias);
              v2u wv; wv.x = pk2(o0, o1); wv.y = pk2(o2, o3); *(v2u*)(MIX + (size_t)(b * SEQ + t0 + tok) * DM + MC_SGU + h * 64 + d) = wv; } } }
    __syncthreads();
}

__device__ __forceinline__ void cmp_unit(const Ctx& C, CA& A, int l, int u) {
    const int b = u >> 4, kv = (u >> 3) & 1, nt = u & 7, lane = C.lane, w = C.wave, tid = C.tid;
    const int c16 = lane & 15, g = lane >> 4, n = nt * 16 + c16;
    const bf16* Z = (const bf16*)(C.ws + WS_Z) + (size_t)b * SEQ * ZP + (kv ? ZC_VC : ZC_KC);
    const bf16* W1T = (const bf16*)(C.ws + WS_CW1) + (size_t)(l * 2 + kv) * 64 * 2048;
    f32x4 acc[4];
#pragma unroll
    for (int et = 0; et < 4; ++et) acc[et] = (f32x4){0.f, 0.f, 0.f, 0.f};
#pragma unroll
    for (int i = 0; i < 8; ++i) { const int ll = 4 * w + (i >> 1), d0 = (i & 1) * 32;
        bf16x8 xf = (bf16x8){0, 0, 0, 0, 0, 0, 0, 0};
        if (n < 127) xf = *(const bf16x8*)(Z + (size_t)(16 * n + ll) * ZP + d0 + g * 8);
#pragma unroll
        for (int et = 0; et < 4; ++et) { const bf16x8 wf = *(const bf16x8*)(W1T + (size_t)(et * 16 + c16) * 2048 + ll * 64 + d0 + g * 8); acc[et] = MFMA16(wf, xf, acc[et]); } }
    float* red = (float*)C.lds;
    float* hid = (float*)(C.lds + 34816);
    float* ob = (float*)(C.lds + 34816 + 4160);
#pragma unroll
    for (int et = 0; et < 4; ++et)
#pragma unroll
        for (int j = 0; j < 4; ++j) red[(w * 64 + et * 16 + g * 4 + j) * 17 + c16] = acc[et][j];
    __syncthreads();
    const float* c0 = (const float*)(C.ws + WS_C0) + (l * 2 + kv) * 64;
#pragma unroll
    for (int q = 0; q < 2; ++q) { const int idx = tid + 512 * q, e = idx & 63, nl = idx >> 6; float s = c0[e];
#pragma unroll
        for (int ww = 0; ww < 8; ++ww) s += red[(ww * 64 + e) * 17 + nl];
        hid[nl * 65 + e] = gelu_tanh(s); }
    __syncthreads();
    const int nl = tid >> 5, e2 = (tid & 31) * 2;
    { const float* w2 = (const float*)A.in[kv ? 22 : 19] + (size_t)l * 4096; float o0 = 0.f, o1 = 0.f;
      for (int e = 0; e < 64; ++e) { const float hv = hid[nl * 65 + e]; const f32x2 wv = *(const f32x2*)(w2 + e * 64 + e2); o0 += hv * wv.x; o1 += hv * wv.y; }
      ob[nl * 64 + e2] = o0; ob[nl * 64 + e2 + 1] = o1; }
    __syncthreads();
    { const int nn = nt * 16 + nl; float v0 = ob[nl * 64 + e2], v1 = ob[nl * 64 + e2 + 1];
      if (nn >= 127) { v0 = 0.f; v1 = 0.f; }
      else if (kv == 0 && e2 < 16) { const size_t tr = (size_t)(b * SEQ + 16 * nn + 31) * 8; const float* ct = (const float*)(C.ws + WS_COS) + tr; const float* st = (const float*)(C.ws + WS_SIN) + tr;
#pragma unroll
          for (int q = 0; q < 2; ++q) { const int e = e2 + q, i = e & 7; const float x1 = ob[nl * 64 + i], x2 = ob[nl * 64 + i + 8], cc = ct[i], ss = st[i];
              const float r = (e < 8) ? (x1 * cc - x2 * ss) : (x2 * cc + x1 * ss); if (q == 0) v0 = r; else v1 = r; } }
      bf16* dst = (bf16*)(C.ws + (kv ? WS_VCMP : WS_KCMP)) + (size_t)(b * 128 + nn) * 64 + e2;
      *(unsigned*)dst = pk2(v0, v1); }
    __syncthreads();
}

__device__ __forceinline__ void rope_pass(const Ctx& C) {
    bf16* Z = (bf16*)(C.ws + WS_Z); const float* ct = (const float*)(C.ws + WS_COS); const float* st = (const float*)(C.ws + WS_SIN);
    for (int idx = C.bid * NTHR + C.tid; idx < M * 6; idx += C.G * NTHR) { const int m = idx / 6, vec = idx - m * 6;
        const int col = vec < 4 ? ZC_Q + vec * 64 : (vec == 4 ? ZC_KS : ZC_KW);
        bf16* p = Z + (size_t)m * ZP + col; const v4u a = *(const v4u*)p, bq = *(const v4u*)(p + 8); float x1[8], x2[8], cc[8], ss[8]; unpack8(a, x1); unpack8(bq, x2);
        { const f32x4 c0 = *(const f32x4*)(ct + (size_t)m * 8), c1 = *(const f32x4*)(ct + (size_t)m * 8 + 4), s0 = *(const f32x4*)(st + (size_t)m * 8), s1 = *(const f32x4*)(st + (size_t)m * 8 + 4);
          cc[0] = c0.x; cc[1] = c0.y; cc[2] = c0.z; cc[3] = c0.w; cc[4] = c1.x; cc[5] = c1.y; cc[6] = c1.z; cc[7] = c1.w; ss[0] = s0.x; ss[1] = s0.y; ss[2] = s0.z; ss[3] = s0.w; ss[4] = s1.x; ss[5] = s1.y; ss[6] = s1.z; ss[7] = s1.w; }
        float y1[8], y2[8];
#pragma unroll
        for (int i = 0; i < 8; ++i) { y1[i] = x1[i] * cc[i] - x2[i] * ss[i]; y2[i] = x2[i] * cc[i] + x1[i] * ss[i]; }
        v4u o1, o2; o1.x = pk2(y1[0], y1[1]); o1.y = pk2(y1[2], y1[3]); o1.z = pk2(y1[4], y1[5]); o1.w = pk2(y1[6], y1[7]); o2.x = pk2(y2[0], y2[1]); o2.y = pk2(y2[2], y2[3]); o2.z = pk2(y2[4], y2[5]); o2.w = pk2(y2[6], y2[7]);
        *(v4u*)p = o1; *(v4u*)(p + 8) = o2; }
}

__device__ __forceinline__ int opaque(int v) { asm volatile("" : "+v"(v)); return v; }
constexpr float SM_C = 0.18033688011112042f;
constexpr float NEG_BIG = -1.0e30f;
constexpr int KV_PITCH = 72;
constexpr int A_KV = 0, KVBUF_BYTES = 2 * 64 * KV_PITCH * 2  ;
constexpr int A_KC = 2 * KVBUF_BYTES  , A_VCT = A_KC + 128 * KV_PITCH * 2  , VCT_PITCH = 136;
constexpr int A_IMP = A_VCT + 64 * VCT_PITCH * 2  , A_VAL = A_IMP + 4 * 64 * 33 * 4  , A_SEL = A_VAL + 64 * 33 * 4  , A_BL = A_SEL + 256, A_END3 = A_BL + 256;
static_assert(A_END3 <= 131072, "P3 LDS map");

__device__ __forceinline__ void attn_block(const bf16* Ks, const bf16* Vt, const bf16x8 (&qf)[2][2], f32x4 (&O)[2][4], float (&mrun)[2], float (&lrun)[2], const int (&lo)[2], const int (&hi)[2], int c16, int g) {
    f32x4 sc[2][4];
#pragma unroll
    for (int kt = 0; kt < 4; ++kt) { const bf16x8 k0 = *(const bf16x8*)(Ks + (kt * 16 + c16) * KV_PITCH + g * 8), k1 = *(const bf16x8*)(Ks + (kt * 16 + c16) * KV_PITCH + 32 + g * 8);
#pragma unroll
        for (int s = 0; s < 2; ++s) { sc[s][kt] = MFMA16(k0, qf[s][0], ((f32x4){0.f, 0.f, 0.f, 0.f})); sc[s][kt] = MFMA16(k1, qf[s][1], sc[s][kt]); } }
#pragma unroll
    for (int s = 0; s < 2; ++s) {
        float mx = NEG_BIG;
#pragma unroll
        for (int kt = 0; kt < 4; ++kt)
#pragma unroll
            for (int j = 0; j < 4; ++j) { const bool ok = (kt * 16 + j >= lo[s]) && (kt * 16 + j <= hi[s]); const float v = ok ? sc[s][kt][j] * SM_C : NEG_BIG; sc[s][kt][j] = v; mx = fmaxf(mx, v); }
        mx = fmaxf(mx, __shfl_xor(mx, 16)); mx = fmaxf(mx, __shfl_xor(mx, 32));
        const float mnew = fmaxf(mrun[s], mx); const float alpha = exp2f(mrun[s] - mnew); float ps = 0.f;
#pragma unroll
        for (int kt = 0; kt < 4; ++kt)
#pragma unroll
            for (int j = 0; j < 4; ++j) { const float v = sc[s][kt][j]; const float p = (v > -1.0e29f) ? exp2f(v - mnew) : 0.f; sc[s][kt][j] = p; ps += p; }
        ps += __shfl_xor(ps, 16); ps += __shfl_xor(ps, 32);
        lrun[s] = lrun[s] * alpha + ps; mrun[s] = mnew;
#pragma unroll
        for (int dt = 0; dt < 4; ++dt) O[s][dt] = O[s][dt] * alpha;
    }
#pragma unroll
    for (int kk = 0; kk < 2; ++kk) { bf16x8 pf[2];
#pragma unroll
        for (int s = 0; s < 2; ++s) { const f32x4 a = sc[s][2 * kk], bq = sc[s][2 * kk + 1]; v4u t; t.x = pk2(a[0], a[1]); t.y = pk2(a[2], a[3]); t.z = pk2(bq[0], bq[1]); t.w = pk2(bq[2], bq[3]); pf[s] = __builtin_bit_cast(bf16x8, t); }
#pragma unroll
        for (int dt = 0; dt < 4; ++dt) { const bf16* vp = Vt + (dt * 16 + c16) * KV_PITCH + (2 * kk) * 16 + g * 4; const v2u v0 = *(const v2u*)vp, v1 = *(const v2u*)(vp + 16);
            v4u t; t.x = v0.x; t.y = v0.y; t.z = v1.x; t.w = v1.y; const bf16x8 vf = __builtin_bit_cast(bf16x8, t);
#pragma unroll
            for (int s = 0; s < 2; ++s) O[s][dt] = MFMA16(vf, pf[s], O[s][dt]); } }
}

__device__ __forceinline__ void attn_branch(const Ctx& C, const bf16* Zb, int type, int nb, int qb, const bf16x8 (&qf)[2][2], const float (&gate)[2], f32x4 (&out)[2][4], int th) {
    const int tid = opaque(C.tid), lane = tid & 63, c16 = lane & 15, g = lane >> 4;
    const int* bl = (const int*)(C.lds + A_BL); const unsigned* selm = (const unsigned*)(C.lds + A_SEL);
    const int kcol = type ? ZC_KS : ZC_KW, vcol = type ? ZC_VS : ZC_VW;
    const int skey = tid >> 3, soct = tid & 7;
    f32x4 O[2][4]; float mrun[2], lrun[2];
#pragma unroll
    for (int s = 0; s < 2; ++s) { mrun[s] = NEG_BIG; lrun[s] = 0.f;
#pragma unroll
        for (int dt = 0; dt < 4; ++dt) O[s][dt] = (f32x4){0.f, 0.f, 0.f, 0.f}; }
    unsigned sm[2]; sm[0] = selm[th * 32 + c16]; sm[1] = selm[th * 32 + 16 + c16];
    v4u kreg, vreg;
    if (nb > 0) { const int J = bl[0]; const bf16* src = Zb + (size_t)(J * 64 + skey) * ZP + soct * 8; kreg = *(const v4u*)(src + kcol); vreg = *(const v4u*)(src + vcol); }
    if (nb > 0) { bf16* Ks = (bf16*)(C.lds + A_KV); bf16* Vt = Ks + 64 * KV_PITCH;
        *(v4u*)(Ks + skey * KV_PITCH + soct * 8) = kreg;
        Vt[(soct * 8 + 0) * KV_PITCH + skey] = (bf16)(vreg.x & 0xffff); Vt[(soct * 8 + 1) * KV_PITCH + skey] = (bf16)(vreg.x >> 16); Vt[(soct * 8 + 2) * KV_PITCH + skey] = (bf16)(vreg.y & 0xffff); Vt[(soct * 8 + 3) * KV_PITCH + skey] = (bf16)(vreg.y >> 16);
        Vt[(soct * 8 + 4) * KV_PITCH + skey] = (bf16)(vreg.z & 0xffff); Vt[(soct * 8 + 5) * KV_PITCH + skey] = (bf16)(vreg.z >> 16); Vt[(soct * 8 + 6) * KV_PITCH + skey] = (bf16)(vreg.w & 0xffff); Vt[(soct * 8 + 7) * KV_PITCH + skey] = (bf16)(vreg.w >> 16); }
    __syncthreads();
    for (int i = 0; i < nb; ++i) {
        const int J = bl[i];
        if (i + 1 < nb) { const int Jn = bl[i + 1]; const bf16* src = Zb + (size_t)(Jn * 64 + skey) * ZP + soct * 8; kreg = *(const v4u*)(src + kcol); vreg = *(const v4u*)(src + vcol); }
        const bf16* Ks = (const bf16*)(C.lds + A_KV + (i & 1) * KVBUF_BYTES); const bf16* Vt = Ks + 64 * KV_PITCH;
        int lo[2], hi[2]; const int rel = qb - J;
#pragma unroll
        for (int s = 0; s < 2; ++s) { const int qo = th * 32 + s * 16 + c16;
            if (type == 0) { lo[s] = (rel == 8) ? qo + 1 : 0; hi[s] = (rel == 0) ? qo : 63; }
            else { const bool sel = (sm[s] >> J) & 1u; lo[s] = sel ? 0 : 200; hi[s] = sel ? ((rel == 0) ? qo : 63) : -200; }
            lo[s] -= 4 * g; hi[s] -= 4 * g; }
        attn_block(Ks, Vt, qf, O, mrun, lrun, lo, hi, c16, g);
        if (i + 1 < nb) { bf16* Kn = (bf16*)(C.lds + A_KV + ((i + 1) & 1) * KVBUF_BYTES); bf16* Vn = Kn + 64 * KV_PITCH;
            *(v4u*)(Kn + skey * KV_PITCH + soct * 8) = kreg;
            Vn[(soct * 8 + 0) * KV_PITCH + skey] = (bf16)(vreg.x & 0xffff); Vn[(soct * 8 + 1) * KV_PITCH + skey] = (bf16)(vreg.x >> 16); Vn[(soct * 8 + 2) * KV_PITCH + skey] = (bf16)(vreg.y & 0xffff); Vn[(soct * 8 + 3) * KV_PITCH + skey] = (bf16)(vreg.y >> 16);
            Vn[(soct * 8 + 4) * KV_PITCH + skey] = (bf16)(vreg.z & 0xffff); Vn[(soct * 8 + 5) * KV_PITCH + skey] = (bf16)(vreg.z >> 16); Vn[(soct * 8 + 6) * KV_PITCH + skey] = (bf16)(vreg.w & 0xffff); Vn[(soct * 8 + 7) * KV_PITCH + skey] = (bf16)(vreg.w >> 16); }
        __syncthreads();
    }
#pragma unroll
    for (int s = 0; s < 2; ++s) { const float f = lrun[s] > 0.f ? gate[s] / lrun[s] : 0.f;
#pragma unroll
        for (int dt = 0; dt < 4; ++dt) out[s][dt] = out[s][dt] + O[s][dt] * f; }
}

__device__ __forceinline__ void nsa_unit(const Ctx& C, int u) {
    const int b = u >> 5, qb = u & 31, t0 = qb * 64, tid = opaque(C.tid), lane = tid & 63, w = __builtin_amdgcn_readfirstlane(tid >> 6);
    const int h = w >> 1, th = w & 1, c16 = lane & 15, g = lane >> 4;
    const bf16* Zb = (const bf16*)(C.ws + WS_Z) + (size_t)b * SEQ * ZP;
    unsigned char* lds = C.lds;
    { const bf16* kc = (const bf16*)(C.ws + WS_KCMP) + (size_t)b * 128 * 64; const bf16* vc = (const bf16*)(C.ws + WS_VCMP) + (size_t)b * 128 * 64;
      bf16* Kc = (bf16*)(lds + A_KC); bf16* Vct = (bf16*)(lds + A_VCT);
#pragma unroll
      for (int q = 0; q < 2; ++q) { const int idx = opaque(tid) + 512 * q, key = idx >> 3, oct = idx & 7;
          const v4u kr = *(const v4u*)(kc + key * 64 + oct * 8), vr = *(const v4u*)(vc + key * 64 + oct * 8);
          *(v4u*)(Kc + key * KV_PITCH + oct * 8) = kr;
          Vct[(oct * 8 + 0) * VCT_PITCH + key] = (bf16)(vr.x & 0xffff); Vct[(oct * 8 + 1) * VCT_PITCH + key] = (bf16)(vr.x >> 16); Vct[(oct * 8 + 2) * VCT_PITCH + key] = (bf16)(vr.y & 0xffff); Vct[(oct * 8 + 3) * VCT_PITCH + key] = (bf16)(vr.y >> 16);
          Vct[(oct * 8 + 4) * VCT_PITCH + key] = (bf16)(vr.z & 0xffff); Vct[(oct * 8 + 5) * VCT_PITCH + key] = (bf16)(vr.z >> 16); Vct[(oct * 8 + 6) * VCT_PITCH + key] = (bf16)(vr.w & 0xffff); Vct[(oct * 8 + 7) * VCT_PITCH + key] = (bf16)(vr.w >> 16); }
      if (tid < 64) ((unsigned*)(lds + A_SEL))[tid] = 0u;
      const int jw0 = qb >= 8 ? qb - 8 : 0; if (tid < 16) ((int*)(lds + A_BL))[tid] = jw0 + tid; }
    bf16x8 qf[2][2]; float gt[2][3];
#pragma unroll
    for (int s = 0; s < 2; ++s) { const bf16* qrow = Zb + (size_t)(t0 + th * 32 + s * 16 + c16) * ZP;
        qf[s][0] = *(const bf16x8*)(qrow + ZC_Q + h * 64 + g * 8); qf[s][1] = *(const bf16x8*)(qrow + ZC_Q + h * 64 + 32 + g * 8);
#pragma unroll
        for (int br = 0; br < 3; ++br) { const unsigned short raw = qrow[ZC_G + h * 3 + br]; gt[s][br] = sigmoidf_(bflo((unsigned)raw)); } }
    f32x4 out[2][4];
#pragma unroll
    for (int s = 0; s < 2; ++s)
#pragma unroll
        for (int dt = 0; dt < 4; ++dt) out[s][dt] = (f32x4){0.f, 0.f, 0.f, 0.f};
    __syncthreads();
    { const bf16* Kc = (const bf16*)(lds + A_KC); const bf16* Vct = (const bf16*)(lds + A_VCT); float* imp = (float*)(lds + A_IMP);
      const int nkt = ((4 * qb + 2) >> 4) + 1;
      f32x4 sc[2][8];
#pragma unroll
      for (int kt = 0; kt < 8; ++kt) {
#pragma unroll
          for (int s = 0; s < 2; ++s) sc[s][kt] = (f32x4){0.f, 0.f, 0.f, 0.f};
          if (kt < nkt) { const bf16x8 k0 = *(const bf16x8*)(Kc + (kt * 16 + c16) * KV_PITCH + g * 8), k1 = *(const bf16x8*)(Kc + (kt * 16 + c16) * KV_PITCH + 32 + g * 8);
#pragma unroll
              for (int s = 0; s < 2; ++s) { sc[s][kt] = MFMA16(k0, qf[s][0], sc[s][kt]); sc[s][kt] = MFMA16(k1, qf[s][1], sc[s][kt]); } } }
#pragma unroll
      for (int s = 0; s < 2; ++s) { const int t = t0 + th * 32 + s * 16 + c16; const int nrel = ((t >= 31) ? ((t - 31) >> 4) : -1) - 4 * g;
          float mx = NEG_BIG;
#pragma unroll
          for (int kt = 0; kt < 8; ++kt)
#pragma unroll
              for (int j = 0; j < 4; ++j) { const float v = (kt * 16 + j <= nrel) ? sc[s][kt][j] * SM_C : NEG_BIG; sc[s][kt][j] = v; mx = fmaxf(mx, v); }
          mx = fmaxf(mx, __shfl_xor(mx, 16)); mx = fmaxf(mx, __shfl_xor(mx, 32));
          float ps = 0.f;
#pragma unroll
          for (int kt = 0; kt < 8; ++kt)
#pragma unroll
              for (int j = 0; j < 4; ++j) { const float v = sc[s][kt][j]; const float p = (v > -1.0e29f) ? exp2f(v - mx) : 0.f; sc[s][kt][j] = p; ps += p; }
          ps += __shfl_xor(ps, 16); ps += __shfl_xor(ps, 32);
          const float inv = ps > 0.f ? 1.0f / ps : 0.f;
#pragma unroll
          for (int kt = 0; kt < 8; ++kt) sc[s][kt] = sc[s][kt] * inv;
          float* irow = imp + (h * 64 + th * 32 + s * 16 + c16) * 33;
          float cprev = 0.f;
#pragma unroll
          for (int kt = 0; kt < 8; ++kt) { const f32x4 p = sc[s][kt]; const float a = 2.f * (p[0] + p[1] + p[2]) + p[3];
              const float up = __shfl(p[3], (lane + 48) & 63);
              const float pv = (g > 0) ? up : cprev; cprev = up;
              irow[kt * 4 + g] = a + pv; }
      }
      f32x4 O[2][4];
#pragma unroll
      for (int s = 0; s < 2; ++s)
#pragma unroll
          for (int dt = 0; dt < 4; ++dt) O[s][dt] = (f32x4){0.f, 0.f, 0.f, 0.f};
#pragma unroll
      for (int kk = 0; kk < 4; ++kk) if (2 * kk < nkt) { bf16x8 pf[2];
#pragma unroll
          for (int s = 0; s < 2; ++s) { const f32x4 a = sc[s][2 * kk], bq = sc[s][2 * kk + 1]; v4u t; t.x = pk2(a[0], a[1]); t.y = pk2(a[2], a[3]); t.z = pk2(bq[0], bq[1]); t.w = pk2(bq[2], bq[3]); pf[s] = __builtin_bit_cast(bf16x8, t); }
#pragma unroll
          for (int dt = 0; dt < 4; ++dt) { const bf16* vp = Vct + (dt * 16 + c16) * VCT_PITCH + (2 * kk) * 16 + g * 4; const v2u v0 = *(const v2u*)vp, v1 = *(const v2u*)(vp + 16);
              v4u t; t.x = v0.x; t.y = v0.y; t.z = v1.x; t.w = v1.y; const bf16x8 vf = __builtin_bit_cast(bf16x8, t);
#pragma unroll
              for (int s = 0; s < 2; ++s) O[s][dt] = MFMA16(vf, pf[s], O[s][dt]); } }
#pragma unroll
      for (int s = 0; s < 2; ++s)
#pragma unroll
          for (int dt = 0; dt < 4; ++dt) out[s][dt] = O[s][dt] * gt[s][0];
    }
    __syncthreads();
    { const float* imp = (const float*)(lds + A_IMP); float* val = (float*)(lds + A_VAL);
#pragma unroll
      for (int q = 0; q < 4; ++q) { const int idx = opaque(tid) + 512 * q, tok = idx >> 5, J = idx & 31; const int back = qb - J;
          float v = ((imp[(0 * 64 + tok) * 33 + J] + imp[(1 * 64 + tok) * 33 + J]) + imp[(2 * 64 + tok) * 33 + J]) + imp[(3 * 64 + tok) * 33 + J];
          if (J == 0 || (back >= 0 && back < 2)) v = 1.0e9f; else if (back < 0) v = -1.0f;
          val[tok * 33 + J] = v; } }
    __syncthreads();
    { const float* val = (const float*)(lds + A_VAL); unsigned* selm = (unsigned*)(lds + A_SEL);
#pragma unroll
      for (int q = 0; q < 4; ++q) { const int idx = opaque(tid) + 512 * q, tok = idx >> 5, J = idx & 31; const float v = val[tok * 33 + J]; int rank = 0;
          for (int j2 = 0; j2 < 32; ++j2) { const float o = val[tok * 33 + j2]; rank += (o > v || (o == v && j2 < J)) ? 1 : 0; }
          if (J <= qb && rank < 8) atomicOr(&selm[tok], 1u << J); } }
    __syncthreads();
    { const int nwin = qb >= 8 ? 9 : qb + 1; float gate[2] = {gt[0][2], gt[1][2]};
      attn_branch(C, Zb, 0, nwin, qb, qf, gate, out, th); }
    { const unsigned* selm = (const unsigned*)(lds + A_SEL); unsigned um = selm[lane];
#pragma unroll
      for (int o = 1; o < 64; o <<= 1) um |= (unsigned)__shfl_xor((int)um, o);
      um = (unsigned)__builtin_amdgcn_readfirstlane((int)um);
      const int nslc = __builtin_popcount(um);
      if (tid == 0) { int* bl = (int*)(lds + A_BL); unsigned r = um; int k = 0; while (r) { const int J = __builtin_ctz(r); r &= r - 1; bl[k++] = J; } }
      __syncthreads();
      float gate[2] = {gt[0][1], gt[1][1]};
      attn_branch(C, Zb, 1, nslc, qb, qf, gate, out, th); }
    { bf16* MIX = (bf16*)(C.ws + WS_MIX); const int lz = opaque(lane), c16 = lz & 15, g = lz >> 4;
#pragma unroll
      for (int s = 0; s < 2; ++s) { bf16* orow = MIX + (size_t)(b * SEQ + t0 + th * 32 + s * 16 + c16) * DM + MC_NSA + h * 64;
#pragma unroll
          for (int dt = 0; dt < 4; ++dt) { const f32x4 o = out[s][dt]; v2u wv; wv.x = pk2(o[0], o[1]); wv.y = pk2(o[2], o[3]); *(v2u*)(orow + dt * 16 + g * 4) = wv; } } }
    __syncthreads();
}

constexpr int N_PHASES = 1 + DEPTH * 8;
__global__ void __launch_bounds__(NTHR, 2) hybrid_fwd(Args args) {
    extern __shared__ __attribute__((aligned(16))) unsigned char lds[];
    Ctx C; C.lds = lds; C.ws = ARGS.ws; C.tid = threadIdx.x; C.lane = C.tid & 63; C.wave = __builtin_amdgcn_readfirstlane(C.tid >> 6); C.G = gridDim.x; C.bid = blockIdx.x;
    const int lo = ARGS.ph_lo, hi = ARGS.ph_hi;
    if (C.tid < 64) ((LAS unsigned*)(LAS unsigned char*)lds)[(LDS_CTL_OFF >> 2) + C.tid] = 0u;
    __syncthreads();
    const XcdBarrier bar = xcd_barrier_post((unsigned*)C.ws, (volatile LAS unsigned*)((LAS unsigned char*)lds + LDS_CTL_OFF));
    int ph = 0;
#define IN(k) (lo <= (k) && (k) < hi)
#define SEAM(k) do { if (IN(k) && IN((k) + 1)) { if ((k) == 0) cg::this_grid().sync(); else xcd_barrier(bar); } } while (0)

#ifndef NO_P0
    if (IN(0)) { const Ctx Cp = fresh(C); p0_prologue(Cp, ARGS); }
#endif

    SEAM(0);
    _Pragma("unroll") for (int l = 0; l < DEPTH; ++l) {
        ph = 1 + l * 8;

        if (IN(ph)) { const Ctx Cp = fresh(C); unsigned char* ws = Cp.ws; pg8::Gemm g{(const pg8::bf16_t*)(ws + WS_XNB), (const pg8::bf16_t*)(ws + WS_WIN) + (size_t)l * ZP * DM, M, ZP, DM}; pg8::StaticOrder S; S.init(M, ZP, Cp.G, Cp.bid);
            pg8::EpiBf16<0> E{(pg8::bf16_t*)(ws + WS_Z), ZP};
            pg8::gemm_phase<pg8::EpiBf16<0>, pg8::StaticOrder, true, true>((LAS unsigned char*)lds, g, S, E); }
        SEAM(ph); ++ph;
        if (IN(ph)) {
            const Ctx Cp = fresh(C);
#ifndef NO_CONV
            for (int u = Cp.bid; u < 256; u += Cp.G) conv_unit(Cp, ARGS, l, u);
#endif


#ifndef NO_POOL
            for (int u = Cp.bid; u < 256; u += Cp.G) pool_unit(Cp, ARGS, l, u);
#endif


#ifndef NO_SGU
            for (int u = Cp.bid; u < 256; u += Cp.G) sgu_unit(Cp, ARGS, l, u);
#endif


#ifndef NO_CMP
            for (int u = Cp.G - 1 - Cp.bid; u < 128; u += Cp.G) cmp_unit(Cp, ARGS, l, u);
#endif


#ifndef NO_ROPE
            rope_pass(Cp);
#endif

        }
        SEAM(ph); ++ph;

#ifndef NO_NSA
        if (IN(ph)) { const Ctx Cp = fresh(C); for (int u = Cp.G - 1 - Cp.bid; u >= 0 && u < 256; u += Cp.G) nsa_unit(Cp, u); }
#endif

        SEAM(ph); ++ph;
        if (IN(ph)) { const Ctx Cp = fresh(C); unsigned char* ws = Cp.ws; pg8::Gemm g{(const pg8::bf16_t*)(ws + WS_MIX), (const pg8::bf16_t*)(ws + WS_WOUT) + (size_t)l * DM * DM, M, DM, DM}; pg8::StaticOrder S; S.init(M, DM, Cp.G, Cp.bid);
            pg8::EpiF32 E{(float*)(ws + WS_Y1), DM};
            pg8::gemm_phase<pg8::EpiF32, pg8::StaticOrder, true, true>((LAS unsigned char*)lds, g, S, E); }
        SEAM(ph); ++ph;
        if (IN(ph)) { CA& A = ARGS; const Ctx Cp = fresh(C); norm_phase(Cp, (const float*)(Cp.ws + WS_Y1), (l == 0) ? (const float*)A.in[0] : (const float*)A.out, A.out, (const float*)A.in[3] + l * DM, (const float*)A.in[4] + l * DM, (bf16*)(Cp.ws + WS_XNA)); }
        SEAM(ph); ++ph;
        if (IN(ph)) { const Ctx Cp = fresh(C); unsigned char* ws = Cp.ws; pg8::Gemm g{(const pg8::bf16_t*)(ws + WS_XNA), (const pg8::bf16_t*)(ws + WS_W1) + (size_t)l * FF * DM, M, FF, DM}; pg8::StaticOrder S; S.init(M, FF, Cp.G, Cp.bid);
            pg8::EpiBf16<2> E{(pg8::bf16_t*)(ws + WS_F), FF};
            pg8::gemm_phase<pg8::EpiBf16<2>, pg8::StaticOrder, true, true>((LAS unsigned char*)lds, g, S, E); }
        SEAM(ph); ++ph;
        if (IN(ph)) { const Ctx Cp = fresh(C); unsigned char* ws = Cp.ws; pg8::Gemm g{(const pg8::bf16_t*)(ws + WS_F), (const pg8::bf16_t*)(ws + WS_W2) + (size_t)l * DM * FF, M, DM, FF}; pg8::StaticOrder S; S.init(M, DM, Cp.G, Cp.bid);
            pg8::EpiF32 E{(float*)(ws + WS_Y2), DM};
            pg8::gemm_phase<pg8::EpiF32, pg8::StaticOrder, true, true>((LAS unsigned char*)lds, g, S, E); }
        SEAM(ph); ++ph;
        if (IN(ph)) { CA& A = ARGS; const Ctx Cp = fresh(C); norm_phase(Cp, (const float*)(Cp.ws + WS_Y2), A.out, A.out, (const float*)A.in[5] + l * DM, (l + 1 < DEPTH) ? (const float*)A.in[2] + (l + 1) * DM : nullptr, (bf16*)(Cp.ws + WS_XNB)); }
        if (l + 1 < DEPTH) SEAM(ph);
    }
#undef IN
#undef SEAM
}

#ifndef MK_MULTI
#define MK_MULTI 0
#endif
extern "C" void kernel_launch(void* const* d_in, const int* in_sizes, int n_in, void* d_out, int out_size, void* d_ws, size_t ws_size, hipStream_t stream) {
    static int grid = 0;
    if (grid == 0) {
        if (n_in != 26 || out_size != M * DM || ws_size < WS_END) { fprintf(stderr, "kernel_launch: unexpected problem (n_in %d, out %d, ws %zu)\n", n_in, out_size, ws_size); grid = -1; return; }
        int dev = 0, cus = 0, per_cu = 0;
        hipGetDevice(&dev); hipDeviceGetAttribute(&cus, hipDeviceAttributeMultiprocessorCount, dev);
        if (hipFuncSetAttribute((const void*)hybrid_fwd, hipFuncAttributeMaxDynamicSharedMemorySize, LDS_BYTES) != hipSuccess) { fprintf(stderr, "kernel_launch: hipFuncSetAttribute failed\n"); grid = -1; return; }
        if (hipOccupancyMaxActiveBlocksPerMultiprocessor(&per_cu, (const void*)hybrid_fwd, NTHR, LDS_BYTES) != hipSuccess || per_cu < 1) { fprintf(stderr, "kernel_launch: occupancy query says %d\n", per_cu); per_cu = 1; }
        (void)hipGetLastError();
        grid = cus * per_cu;
        fprintf(stderr, "kernel_launch: grid %d (cus %d x %d)\n", grid, cus, per_cu);
    }
    if (grid < 0) return;
    if (hipMemsetAsync((char*)d_ws + WS_BAR, 0, BAR_ZERO_BYTES, stream) != hipSuccess) { fprintf(stderr, "kernel_launch: hipMemsetAsync failed\n"); return; }
    Args a{};
    for (int i = 0; i < 26; ++i) a.in[i] = d_in[i];
    a.out = (float*)d_out; a.ws = (unsigned char*)d_ws;
#if MK_MULTI
    for (int p = 0; p < N_PHASES; ++p) { a.ph_lo = p; a.ph_hi = p + 1; hipLaunchKernelGGL(hybrid_fwd, dim3(grid), dim3(NTHR), LDS_BYTES, stream, a); }
#else
    a.ph_lo = 0; a.ph_hi = N_PHASES;
    void* kargs[] = {&a};
    hipError_t e = hipLaunchCooperativeKernel((const void*)hybrid_fwd, dim3(grid), dim3(NTHR), kargs, LDS_BYTES, stream);
    if (e != hipSuccess) fprintf(stderr, "kernel_launch: cooperative launch failed: %s (grid %d)\n", hipGetErrorString(e), grid);
#endif
}
```

```cpp
#include <hip/hip_runtime.h>
#include <hip/hip_cooperative_groups.h>
#include <cstdio>
#include <cstdint>
namespace cg = cooperative_groups;
namespace pg8 {
#define PG8_LAS __attribute__((address_space(3)))
typedef unsigned short bf16_t;
typedef short bf16x8 __attribute__((ext_vector_type(8)));
typedef float f32x4 __attribute__((ext_vector_type(4)));
typedef unsigned u32x4 __attribute__((ext_vector_type(4)));
constexpr int BM = 256, BK = 64, HALF = 128, HTB = HALF * BK * 2  , STAGE_BYTES = 8 * HTB, NXCD = 8, WGM = 8;

__host__ __device__ __forceinline__ int lds_byte(int r, int c) { const int st = (r >> 4) * 2 + (c >> 5), rr = r & 15, cc = c & 31, ob = rr * 64 + cc * 2; return st * 1024 + (ob ^ (((ob >> 9) & 1) << 5)); }
__host__ __device__ __forceinline__ void stage_rc(int b, int& R, int& C) { const int st = b / 1024, sb = b % 1024, swz = sb ^ (((sb >> 9) & 1) << 5); R = (st >> 1) * 16 + swz / 64; C = (st & 1) * 32 + (swz % 64) / 2; }
__host__ __device__ __forceinline__ int perm32(int rho) { const int n = rho >> 4, i = rho & 15; return 8 * (i >> 2) + 4 * n + (i & 3); }

struct Unit { int pm, pn; };
struct Gemm { const bf16_t* A; const bf16_t* Bt; int M, N, K; };

struct StaticOrder {
    int nM, nN, nwg, G, c;
    __host__ __device__ void init(int M, int N, int G_, int c_) { nM = M / BM; nN = N / BM; nwg = nM * nN; G = G_; c = c_; }
    __host__ __device__ bool next(int i, Unit& u) const {
        const long L = (long)i * G + c; if (L >= nwg) return false;
        int wgid = (int)L; { const int q = nwg / NXCD, r = nwg % NXCD, xcd = wgid % NXCD, off = wgid / NXCD; wgid = (xcd < r ? xcd * (q + 1) : r * (q + 1) + (xcd - r) * q) + off; }
        const int nig = WGM * nN, gid = wgid / nig, fm = gid * WGM, gsz = (nM - fm) < WGM ? (nM - fm) : WGM;
        u.pm = fm + ((wgid % nig) % gsz); u.pn = (wgid % nig) / gsz; return true;
    }
    __device__ __forceinline__ void a_ready(const Unit&) const {}
    __device__ __forceinline__ void done(const Unit&) const {}
};

__device__ __forceinline__ unsigned cvt_pk_bf16(float lo, float hi) { unsigned r; asm volatile("v_cvt_pk_bf16_f32 %0, %1, %2" : "=v"(r) : "v"(lo), "v"(hi)); return r; }
typedef float f32x2 __attribute__((ext_vector_type(2)));
template <int ACT  > struct EpiBf16 {
    static constexpr bool PERM = true, AFTER_DRAIN = false;
    bf16_t* O; int ldc;
    __device__ __forceinline__ void operator()(const f32x4 (&acc)[2][2][4][2], const Unit& u, int wr, int wc, int fr, int fq) const {
        const int row0 = u.pm * BM + wr * 64 + fr; const int col0 = u.pn * BM + wc * 32 + 8 * fq;
#pragma unroll
        for (int ai = 0; ai < 2; ++ai)
#pragma unroll
            for (int m = 0; m < 4; ++m) { bf16_t* rowp = O + (size_t)(row0 + ai * HALF + m * 16) * ldc + col0;
#pragma unroll
                for (int bj = 0; bj < 2; ++bj) { f32x4 v0 = acc[ai][bj][m][0], v1 = acc[ai][bj][m][1];
                    if (ACT == 2) {
#pragma unroll
                        for (int j = 0; j < 4; ++j) { const float a = v0[j] > 0.f ? v0[j] : 0.f, b = v1[j] > 0.f ? v1[j] : 0.f; v0[j] = a * a; v1[j] = b * b; } }
                    u32x4 w; w.x = cvt_pk_bf16(v0[0], v0[1]); w.y = cvt_pk_bf16(v0[2], v0[3]); w.z = cvt_pk_bf16(v1[0], v1[1]); w.w = cvt_pk_bf16(v1[2], v1[3]);
                    *(u32x4*)(rowp + bj * HALF) = w; } }
    }
};
struct EpiF32 {
    static constexpr bool PERM = false, AFTER_DRAIN = false;
    float* O; int ldc;
    __device__ __forceinline__ void operator()(const f32x4 (&acc)[2][2][4][2], const Unit& u, int wr, int wc, int fr, int fq) const {
        const int row0 = u.pm * BM + wr * 64 + fr; const int col0 = u.pn * BM + wc * 32 + 4 * fq;
#pragma unroll
        for (int ai = 0; ai < 2; ++ai)
#pragma unroll
            for (int m = 0; m < 4; ++m) { float* rowp = O + (size_t)(row0 + ai * HALF + m * 16) * ldc + col0;
#pragma unroll
                for (int bj = 0; bj < 2; ++bj)
#pragma unroll
                    for (int n = 0; n < 2; ++n) *(f32x4*)(rowp + bj * HALF + n * 16) = acc[ai][bj][m][n]; }
    }
};
template <class Epi, class Sched, bool ALIGN_EPI = false, bool SP2 = false>
__device__ __forceinline__ void gemm_phase(PG8_LAS unsigned char* lds, const Gemm g, const Sched& S, const Epi& E) {
    int tid_ = threadIdx.x; asm volatile("" : "+v"(tid_)); const int tid = tid_, wid = __builtin_amdgcn_readfirstlane(tid >> 6), lane = tid & 63, wr = wid >> 2, wc = wid & 3, fr = lane & 15, fq = lane >> 4;
    const int K = g.K, nt = K / BK;
    unsigned voffA[2], voffB[2];
#pragma unroll
    for (int i = 0; i < 2; ++i) { int R, C; stage_rc(tid * 16 + i * 8192, R, C); const int Rb = Epi::PERM ? ((R & ~31) + perm32(R & 31)) : R;
        voffA[i] = (unsigned)(R * K + C) * 2u; voffB[i] = (unsigned)(Rb * K + C) * 2u; }
    const size_t kstep = (size_t)(BK * 2);
    const size_t hstep = (size_t)HALF * K * 2;
    const size_t tstep = 2 * hstep;
    const unsigned ldsw = (unsigned)wid * 1024u;
    const int aoff = lds_byte(wr * 64 + fr, fq * 8), boff = lds_byte(wc * 32 + fr, fq * 8);
#define PG8_SA(b, h) (((b) * 2 + (h)) * HTB)
#define PG8_SB(b, h) ((4 + (b) * 2 + (h)) * HTB)
#define PG8_STAGE(bufoff, gbase, voff) do { _Pragma("unroll") for (int _i = 0; _i < 2; ++_i) \
        __builtin_amdgcn_global_load_lds((const unsigned*)((const char*)(gbase) + (voff)[_i]), (PG8_LAS unsigned*)(lds + (bufoff) + ldsw + _i * 8192), 16, 0, 0); } while (0)
#define PG8_LDA(dst, b, h) do { _Pragma("unroll") for (int m = 0; m < 4; ++m) _Pragma("unroll") for (int k = 0; k < 2; ++k) dst[m][k] = *(const PG8_LAS bf16x8*)(lds + PG8_SA(b, h) + aoff + m * 2048 + k * 1024); } while (0)
#define PG8_LDB(dst, b, h) do { _Pragma("unroll") for (int n = 0; n < 2; ++n) _Pragma("unroll") for (int k = 0; k < 2; ++k) dst[n][k] = *(const PG8_LAS bf16x8*)(lds + PG8_SB(b, h) + boff + n * 2048 + k * 1024); } while (0)
#define PG8_MMA(ai, bj, At, Bt) do { __builtin_amdgcn_s_setprio(1); _Pragma("unroll") for (int m = 0; m < 4; ++m) _Pragma("unroll") for (int n = 0; n < 2; ++n) _Pragma("unroll") for (int k = 0; k < 2; ++k) \
        acc[ai][bj][m][n] = __builtin_amdgcn_mfma_f32_16x16x32_bf16(Bt[n][k], At[m][k], acc[ai][bj][m][n], 0, 0, 0); __builtin_amdgcn_s_setprio(0); } while (0)
#define PG8_WAIT_V(n) asm volatile("s_waitcnt vmcnt(" #n ")" ::: "memory")
#define PG8_WAIT_L(n) asm volatile("s_waitcnt lgkmcnt(" #n ")" ::: "memory")
#define PG8_BAR __builtin_amdgcn_s_barrier()
#define PG8_SCHED __builtin_amdgcn_sched_barrier(0)
    Unit cur, nxt; int ui = 0;
    if (!S.next(0, cur)) return;
    f32x4 acc[2][2][4][2];
#pragma unroll
    for (int a = 0; a < 2; ++a)
#pragma unroll
        for (int b = 0; b < 2; ++b)
#pragma unroll
            for (int m = 0; m < 4; ++m)
#pragma unroll
                for (int n = 0; n < 2; ++n) acc[a][b][m][n] = (f32x4){0.f, 0.f, 0.f, 0.f};
    bf16x8 At[4][2], B0[2][2], B1[2][2];
    const char* cA = (const char*)g.A + (size_t)cur.pm * tstep; const char* cB = (const char*)g.Bt + (size_t)cur.pn * tstep;
    S.a_ready(cur);
    if constexpr (SP2) {
        PG8_STAGE(PG8_SB(0, 0), cB, voffB); PG8_STAGE(PG8_SB(0, 1), cB + hstep, voffB); PG8_STAGE(PG8_SA(0, 0), cA, voffA); PG8_STAGE(PG8_SA(0, 1), cA + hstep, voffA);
        if (wr == 1) PG8_BAR;
        PG8_WAIT_V(2); PG8_BAR;
        PG8_STAGE(PG8_SB(1, 0), cB + kstep, voffB); PG8_STAGE(PG8_SA(1, 0), cA + kstep, voffA); PG8_STAGE(PG8_SB(1, 1), cB + hstep + kstep, voffB);
        PG8_WAIT_V(6); PG8_BAR;
    } else {
        PG8_STAGE(PG8_SB(0, 0), cB, voffB); PG8_STAGE(PG8_SA(0, 0), cA, voffA); PG8_STAGE(PG8_SB(0, 1), cB + hstep, voffB); PG8_STAGE(PG8_SA(0, 1), cA + hstep, voffA);
        if (wr == 1) PG8_BAR;
        PG8_WAIT_V(4); PG8_BAR;
        PG8_STAGE(PG8_SB(1, 0), cB + kstep, voffB); PG8_STAGE(PG8_SA(1, 0), cA + kstep, voffA); PG8_STAGE(PG8_SB(1, 1), cB + hstep + kstep, voffB);
        PG8_WAIT_V(6); PG8_BAR;
    }
    for (;;) {
        const bool has_next = S.next(ui + 1, nxt);
        const char* nA = has_next ? (const char*)g.A + (size_t)nxt.pm * tstep : cA; const char* nB = has_next ? (const char*)g.Bt + (size_t)nxt.pn * tstep : cB;
        for (int t = 0; t < nt; t += 2) {
            const bool last = (t == nt - 2);
            const char* a1 = cA + (size_t)(t + 1) * kstep;
            const char* a2 = last ? nA : cA + (size_t)(t + 2) * kstep; const char* b2 = last ? nB : cB + (size_t)(t + 2) * kstep;
            const char* a3 = a2 + kstep; const char* b3 = b2 + kstep;
            if (last && has_next) S.a_ready(nxt);
            if constexpr (SP2) {
            PG8_LDB(B0, 0, 0); PG8_LDB(B1, 0, 1); PG8_SCHED; PG8_LDA(At, 0, 0); PG8_STAGE(PG8_SA(1, 1), a1 + hstep, voffA);
            PG8_WAIT_V(8); PG8_WAIT_L(0); PG8_BAR; PG8_MMA(0, 0, At, B0); PG8_MMA(0, 1, At, B1); PG8_BAR; PG8_SCHED;
            PG8_LDA(At, 0, 1); PG8_STAGE(PG8_SB(0, 0), b2, voffB); PG8_STAGE(PG8_SB(0, 1), b2 + hstep, voffB); PG8_STAGE(PG8_SA(0, 0), a2, voffA);
            PG8_WAIT_V(8); PG8_WAIT_L(0); PG8_BAR; PG8_MMA(1, 0, At, B0); PG8_MMA(1, 1, At, B1); PG8_BAR; PG8_SCHED;
            PG8_LDB(B0, 1, 0); PG8_LDB(B1, 1, 1); PG8_SCHED; PG8_LDA(At, 1, 0); PG8_STAGE(PG8_SA(0, 1), a2 + hstep, voffA);
            PG8_WAIT_V(8); PG8_WAIT_L(0); PG8_BAR; PG8_MMA(0, 0, At, B0); PG8_MMA(0, 1, At, B1); PG8_BAR; PG8_SCHED;
            PG8_LDA(At, 1, 1); PG8_STAGE(PG8_SB(1, 0), b3, voffB); PG8_STAGE(PG8_SB(1, 1), b3 + hstep, voffB); PG8_STAGE(PG8_SA(1, 0), a3, voffA);
            PG8_WAIT_V(8); PG8_WAIT_L(0); PG8_BAR; PG8_MMA(1, 0, At, B0); PG8_MMA(1, 1, At, B1); PG8_BAR; PG8_SCHED;
            } else {
            PG8_LDB(B0, 0, 0); PG8_SCHED; PG8_LDA(At, 0, 0); PG8_STAGE(PG8_SA(1, 1), a1 + hstep, voffA);
            PG8_WAIT_L(8); PG8_BAR; PG8_WAIT_L(0); PG8_MMA(0, 0, At, B0); PG8_BAR; PG8_SCHED;
            PG8_LDB(B1, 0, 1); PG8_STAGE(PG8_SB(0, 0), b2, voffB);
            PG8_BAR; PG8_WAIT_L(0); PG8_MMA(0, 1, At, B1); PG8_BAR;
            PG8_LDA(At, 0, 1); PG8_STAGE(PG8_SA(0, 0), a2, voffA);
            PG8_BAR; PG8_WAIT_L(0); PG8_MMA(1, 0, At, B0); PG8_BAR; PG8_SCHED;
            PG8_STAGE(PG8_SB(0, 1), b2 + hstep, voffB);
            PG8_WAIT_V(6); PG8_BAR; PG8_MMA(1, 1, At, B1); PG8_BAR;
            PG8_LDB(B0, 1, 0); PG8_SCHED; PG8_LDA(At, 1, 0); PG8_STAGE(PG8_SA(0, 1), a2 + hstep, voffA);
            PG8_WAIT_L(8); PG8_BAR; PG8_WAIT_L(0); PG8_MMA(0, 0, At, B0); PG8_BAR; PG8_SCHED;
            PG8_LDB(B1, 1, 1); PG8_STAGE(PG8_SB(1, 0), b3, voffB);
            PG8_BAR; PG8_WAIT_L(0); PG8_MMA(0, 1, At, B1); PG8_BAR;
            PG8_LDA(At, 1, 1); PG8_STAGE(PG8_SA(1, 0), a3, voffA);
            PG8_BAR; PG8_WAIT_L(0); PG8_MMA(1, 0, At, B0); PG8_BAR; PG8_SCHED;
            PG8_STAGE(PG8_SB(1, 1), b3 + hstep, voffB);
            PG8_WAIT_V(6); PG8_BAR; PG8_MMA(1, 1, At, B1); PG8_BAR;
            }
        }
        if constexpr (ALIGN_EPI) { if (wr == 0) PG8_BAR; }
        if constexpr (!Epi::AFTER_DRAIN) { E(acc, cur, wr, wc, fr, fq); S.done(cur); }
        if (!has_next) break;
#pragma unroll
        for (int a = 0; a < 2; ++a)
#pragma unroll
            for (int b = 0; b < 2; ++b)
#pragma unroll
                for (int m = 0; m < 4; ++m)
#pragma unroll
                    for (int n = 0; n < 2; ++n) acc[a][b][m][n] = (f32x4){0.f, 0.f, 0.f, 0.f};
        cur = nxt; cA = nA; cB = nB; ++ui;
        if constexpr (ALIGN_EPI) { if (wr == 1) PG8_BAR; }
    }
    PG8_WAIT_V(0);
    if constexpr (!ALIGN_EPI) { if (wr == 0) PG8_BAR; }
    PG8_BAR;
    if constexpr (Epi::AFTER_DRAIN) { E.fused(acc, cur, wr, wc, fr, fq, lds, wid, lane); S.done(cur); }
#undef PG8_SA
#undef PG8_SB
#undef PG8_STAGE
#undef PG8_LDA
#undef PG8_LDB
#undef PG8_MMA
#undef PG8_WAIT_V
#undef PG8_WAIT_L
#undef PG8_BAR
#undef PG8_SCHED
}
}

constexpr int NWAVES = 8, NTHR = 512;
constexpr int BATCH = 8, SEQ = 2048, DM = 1024, DIN = 1932, ZP = 2048, FF = 4096, DEPTH = 2;
constexpr int M = BATCH * SEQ;
constexpr float NORM_EPS = 1e-6f;
constexpr int ZC_CVAL = 0, ZC_CGATE = 256, ZC_POOL = 512, ZC_SU = 768, ZC_SV = 1024, ZC_Q = 1280, ZC_KC = 1536, ZC_VC = 1600, ZC_KS = 1664, ZC_VS = 1728, ZC_KW = 1792, ZC_VW = 1856, ZC_G = 1920;
constexpr int MC_CONV = 0, MC_POOL = 256, MC_SGU = 512, MC_NSA = 768;
constexpr size_t MiB = 1u << 20, KiB = 1u << 10;
constexpr size_t WS_WIN = 1 * MiB, WS_WOUT = 9 * MiB, WS_W1 = 13 * MiB, WS_W2 = 29 * MiB, WS_CW1 = 45 * MiB;
constexpr size_t WS_SGUW = 46 * MiB, WS_POOLW = 46 * MiB + 256 * KiB, WS_C0 = 46 * MiB + 384 * KiB, WS_COS = 46 * MiB + 512 * KiB, WS_SIN = 47 * MiB;
constexpr size_t WS_KCMP = 47 * MiB + 512 * KiB, WS_VCMP = 47 * MiB + 640 * KiB;
constexpr size_t WS_XNA = 48 * MiB, WS_Y2 = 48 * MiB;
constexpr size_t WS_Z = 128 * MiB, WS_Y1 = 128 * MiB;
constexpr size_t WS_MIX = 192 * MiB, WS_XNB = 224 * MiB;
constexpr size_t WS_F = 128 * MiB, WS_END = 256 * MiB;
constexpr int LDS_BYTES = 147456;
constexpr int LDS_CTL_OFF = 131072;
constexpr size_t WS_BAR = 0, BAR_ZERO_BYTES = 16384;

typedef unsigned short bf16;
typedef unsigned v4u __attribute__((ext_vector_type(4)));
typedef unsigned v2u __attribute__((ext_vector_type(2)));
typedef float f32x4 __attribute__((ext_vector_type(4)));
typedef float f32x2 __attribute__((ext_vector_type(2)));
typedef short bf16x8 __attribute__((ext_vector_type(8)));
typedef short s16x4 __attribute__((ext_vector_type(4)));
#define LAS __attribute__((address_space(3)))
#define MFMA16(a, b, c) __builtin_amdgcn_mfma_f32_16x16x32_bf16((a), (b), (c), 0, 0, 0)

__device__ __forceinline__ unsigned f2bf(float f) { unsigned u = __builtin_bit_cast(unsigned, f); return (u + 0x7fffu + ((u >> 16) & 1u)) >> 16; }
__device__ __forceinline__ unsigned pk2(float lo, float hi) { return f2bf(lo) | (f2bf(hi) << 16); }
__device__ __forceinline__ float bflo(unsigned w) { return __builtin_bit_cast(float, w << 16); }
__device__ __forceinline__ float bfhi(unsigned w) { return __builtin_bit_cast(float, w & 0xffff0000u); }
__device__ __forceinline__ float wave_sum(float v) {
#pragma unroll
    for (int o = 1; o < 64; o <<= 1) v += __shfl_xor(v, o);
    return v;
}
__device__ __forceinline__ float sigmoidf_(float x) { return 1.0f / (1.0f + __expf(-x)); }
__device__ __forceinline__ float gelu_tanh(float x) {
    const float y = 0.7978845608028654f * (x + 0.044715f * x * x * x);
    const float t = 1.0f - 2.0f / (__expf(2.0f * y) + 1.0f);
    return 0.5f * x * (1.0f + t);
}

#define RLX_AGENT __ATOMIC_RELAXED, __HIP_MEMORY_SCOPE_AGENT
#define XB_TMO      128
#define XB_XCNT(j)  (256  + 64 * (j))
#define XB_XSUB(j)  (1280 + 64 * (j))
#define XB_XGEN(j)  (2304 + 64 * (j))
#define XB_TOP      3328
#define XB_TOPGEN   3392
#define XCD_BAR_WORDS 3456
#define XB_SPIN_CAP (1u << 18)

__device__ __forceinline__ unsigned xb_ld(unsigned* p)              { return __hip_atomic_load(p, __ATOMIC_RELAXED, __HIP_MEMORY_SCOPE_AGENT); }
__device__ __forceinline__ unsigned xb_add(unsigned* p, unsigned v) { return __hip_atomic_fetch_add(p, v, __ATOMIC_RELAXED, __HIP_MEMORY_SCOPE_AGENT); }
__device__ __forceinline__ unsigned xb_xcc_id() { return (unsigned)__builtin_amdgcn_s_getreg((3 << 11) | 20) & 0xFu; }
#define XB_SPIN(cond, bar) do { unsigned _sp = 0; while (cond) { __builtin_amdgcn_s_sleep(1); \
    if ((++_sp & 255u) == 0u) { if (xb_ld(&(bar)[XB_TMO])) break; if (_sp > XB_SPIN_CAP) { atomicAdd(&(bar)[XB_TMO], 1u); break; } } } } while (0)

struct XcdBarrier {
    unsigned* bar; unsigned x;
    volatile LAS unsigned* st;
};

__device__ __forceinline__ XcdBarrier xcd_barrier_post(unsigned* bar, volatile LAS unsigned* st) {
    XcdBarrier b; b.bar = bar; b.x = xb_xcc_id(); b.st = st;
    if (threadIdx.x == 0) (void)xb_add(&bar[XB_XCNT(b.x)], 1u);
    return b;
}
__device__ __forceinline__ void xcd_barrier_complete(unsigned* bar, unsigned x, unsigned& nloc, unsigned& nx) {
    const unsigned G = gridDim.x * gridDim.y * gridDim.z;
    unsigned sum, cnt, mine, sp = 0u;
    for (;;) {
        sum = 0u; cnt = 0u; mine = 0u;
#pragma unroll
        for (unsigned j = 0; j < 16; ++j) { const unsigned c = xb_ld(&bar[XB_XCNT(j)]); sum += c; cnt += (c > 0u) ? 1u : 0u; mine = (j == x) ? c : mine; }
        if (sum == G) break;
        __builtin_amdgcn_s_sleep(1);
        if ((++sp & 255u) == 0u) { if (xb_ld(&bar[XB_TMO])) break; if (sp > XB_SPIN_CAP) { atomicAdd(&bar[XB_TMO], 1u); break; } }
    }
    nloc = mine > 0u ? mine : 1u; nx = cnt > 0u ? cnt : 1u;
}

__device__ __forceinline__ void xcd_barrier(const XcdBarrier& b) {
    asm volatile("s_waitcnt vmcnt(0)" ::: "memory");
    __syncthreads();
    if (threadIdx.x == 0) {
        unsigned* bar = b.bar;
        __builtin_amdgcn_s_waitcnt(0);
        unsigned nloc = b.st[0], nx = b.st[1];
        if (nloc == 0u) { xcd_barrier_complete(bar, b.x, nloc, nx); b.st[0] = nloc; b.st[1] = nx; }
        const unsigned old = xb_add(&bar[XB_XSUB(b.x)], 1u);
        const unsigned gen = old / nloc;
        if (old + 1u == (gen + 1u) * nloc) {
            __builtin_amdgcn_fence(__ATOMIC_RELEASE, "agent");
            asm volatile("s_waitcnt vmcnt(0)" ::: "memory");
            const unsigned og = xb_add(&bar[XB_TOP], 1u);
            const unsigned tg = og / nx;
            if (og + 1u == (tg + 1u) * nx) xb_add(&bar[XB_TOPGEN], 1u);
            else XB_SPIN(xb_ld(&bar[XB_TOPGEN]) == tg, bar);
            __builtin_amdgcn_fence(__ATOMIC_ACQUIRE, "agent");
            xb_add(&bar[XB_XGEN(b.x)], 1u);
            asm volatile("s_waitcnt vmcnt(0)" ::: "memory");
        } else {
            XB_SPIN(xb_ld(&bar[XB_XGEN(b.x)]) == gen, bar);
            __builtin_amdgcn_fence(__ATOMIC_ACQUIRE, "agent");
            asm volatile("s_waitcnt vmcnt(0)" ::: "memory");
        }
    }
    __syncthreads();
}

struct Args { const void* in[26]; float* out; unsigned char* ws; int ph_lo, ph_hi; };
typedef const __attribute__((address_space(4))) Args CA;
__device__ __forceinline__ CA* get_args() { CA* p = (CA*)__builtin_amdgcn_kernarg_segment_ptr(); asm volatile("" : "+s"(p)); return p; }
#define ARGS (*get_args())

struct Ctx {
    unsigned char* lds; unsigned char* ws;
    int tid, lane, wave, G, bid;
};

__device__ __forceinline__ Ctx fresh(const Ctx& C0) { Ctx C = C0; int t = C0.tid; asm volatile("" : "+v"(t)); C.tid = t; C.lane = t & 63; C.wave = __builtin_amdgcn_readfirstlane(t >> 6); int b = C0.bid; asm volatile("" : "+s"(b)); C.bid = b; unsigned char* w = C0.ws; asm volatile("" : "+s"(w)); C.ws = w; return C; }
__device__ __forceinline__ void p0_transpose_item(const float* W, int K, int Nsrc, int Npad, bf16* WT, float* scr, int item, int lane) {
    const int nblk = Npad / 32, kb = item / nblk, nb = item % nblk, k0 = 64 * kb, n0 = 32 * nb;
    const int nn = n0 + (lane & 31);
#pragma unroll 8
    for (int i = 0; i < 32; ++i) { const int kk = 2 * i + (lane >> 5); scr[kk * 33 + (lane & 31)] = (nn < Nsrc) ? W[(size_t)(k0 + kk) * Nsrc + nn] : 0.f; }
    asm volatile("s_waitcnt lgkmcnt(0)" ::: "memory");
    const int c = lane & 7;
#pragma unroll
    for (int j = 0; j < 4; ++j) { const int n = (lane >> 3) + 8 * j; const float* s = scr + (8 * c) * 33 + n;
        v4u o; o.x = pk2(s[0 * 33], s[1 * 33]); o.y = pk2(s[2 * 33], s[3 * 33]); o.z = pk2(s[4 * 33], s[5 * 33]); o.w = pk2(s[6 * 33], s[7 * 33]);
        *(v4u*)(WT + (size_t)(n0 + n) * K + k0 + 8 * c) = o; }
    asm volatile("s_waitcnt lgkmcnt(0)" ::: "memory");
}
__device__ __forceinline__ void norm_row(const float* y, const float* xin, float* xout, const float* gpost, const float* gnext, bf16* xn, int lane) {
    f32x4 v[4];
#pragma unroll
    for (int j = 0; j < 4; ++j) v[j] = *((const f32x4*)xin + lane + 64 * j);
    if (y) {
        f32x4 yv[4]; float s = 0.f;
#pragma unroll
        for (int j = 0; j < 4; ++j) { yv[j] = *((const f32x4*)y + lane + 64 * j); s += (yv[j].x * yv[j].x + yv[j].y * yv[j].y) + (yv[j].z * yv[j].z + yv[j].w * yv[j].w); }
        const float r = 1.0f / sqrtf(wave_sum(s) * (1.f / DM) + NORM_EPS);
#pragma unroll
        for (int j = 0; j < 4; ++j) { const f32x4 g = *((const f32x4*)gpost + lane + 64 * j); v[j] = v[j] + yv[j] * r * g; *((f32x4*)xout + lane + 64 * j) = v[j]; }
    }
    if (gnext) {
        float s = 0.f;
#pragma unroll
        for (int j = 0; j < 4; ++j) s += (v[j].x * v[j].x + v[j].y * v[j].y) + (v[j].z * v[j].z + v[j].w * v[j].w);
        const float r = 1.0f / sqrtf(wave_sum(s) * (1.f / DM) + NORM_EPS);
#pragma unroll
        for (int j = 0; j < 4; ++j) { const f32x4 g = *((const f32x4*)gnext + lane + 64 * j); const f32x4 o = v[j] * r * g;
            v2u w; w.x = pk2(o.x, o.y); w.y = pk2(o.z, o.w); *((v2u*)xn + lane + 64 * j) = w; }
    }
}
__device__ __forceinline__ void norm_phase(const Ctx& C, const float* Y, const float* xin, float* xout, const float* gpost, const float* gnext, bf16* XN) {
    const int gw = C.bid * NWAVES + C.wave, NGW = C.G * NWAVES;
    for (int m = gw; m < M; m += NGW) norm_row(Y ? Y + (size_t)m * DM : nullptr, xin + (size_t)m * DM, xout ? xout + (size_t)m * DM : nullptr, gpost, gnext, XN + (size_t)m * DM, C.lane);
}

__device__ __forceinline__ void p0_prologue(const Ctx& C, CA& A) {
    float* scr = (float*)(C.lds + C.wave * 16384);
    unsigned char* ws = C.ws;
    const int gw = C.bid * NWAVES + C.wave, NGW = C.G * NWAVES;
    constexpr int I_IN = (DM / 64) * (ZP / 32), I_OUT = (DM / 64) * (DM / 32), I_1 = (DM / 64) * (FF / 32), I_2 = (FF / 64) * (DM / 32), I_CW = (2048 / 64) * (64 / 32), I_PW = 2;
    constexpr int PER_L = I_IN + I_OUT + I_1 + I_2 + 2 * I_CW + 4 * I_PW;
    for (int it = gw; it < DEPTH * PER_L; it += NGW) {
        const int l = it / PER_L; int r = it % PER_L;
        if (r < I_IN) { p0_transpose_item((const float*)A.in[6] + (size_t)l * DM * DIN, DM, DIN, ZP, (bf16*)(ws + WS_WIN) + (size_t)l * ZP * DM, scr, r, C.lane); continue; } r -= I_IN;
        if (r < I_OUT) { p0_transpose_item((const float*)A.in[23] + (size_t)l * DM * DM, DM, DM, DM, (bf16*)(ws + WS_WOUT) + (size_t)l * DM * DM, scr, r, C.lane); continue; } r -= I_OUT;
        if (r < I_1) { p0_transpose_item((const float*)A.in[24] + (size_t)l * DM * FF, DM, FF, FF, (bf16*)(ws + WS_W1) + (size_t)l * FF * DM, scr, r, C.lane); continue; } r -= I_1;
        if (r < I_2) { p0_transpose_item((const float*)A.in[25] + (size_t)l * FF * DM, FF, DM, DM, (bf16*)(ws + WS_W2) + (size_t)l * DM * FF, scr, r, C.lane); continue; } r -= I_2;
        if (r < 2 * I_CW) { const int kv = r / I_CW; p0_transpose_item((const float*)A.in[kv ? 21 : 18] + (size_t)l * 2048 * 64, 2048, 64, 64, (bf16*)(ws + WS_CW1) + (size_t)(l * 2 + kv) * 64 * 2048, scr, r % I_CW, C.lane); continue; } r -= 2 * I_CW;
        { const int gi = r / I_PW; p0_transpose_item((const float*)A.in[11] + (size_t)(l * 4 + gi) * 4096, 64, 64, 64, (bf16*)(ws + WS_POOLW) + (size_t)(l * 4 + gi) * 4096, scr, r % I_PW, C.lane); }
    }
    { const float* sw = (const float*)A.in[15]; bf16* dst = (bf16*)(ws + WS_SGUW);
      for (int i = C.bid * NTHR + C.tid; i < DEPTH * 4 * 128 * 128; i += C.G * NTHR) { const int s = i & 127, t = (i >> 7) & 127; dst[i] = (bf16)f2bf(s <= t ? sw[i] : 0.f); } }
    if (gw < DEPTH * 2 * 8) { const int l = gw >> 4, kv = (gw >> 3) & 1, eg = gw & 7; const float* pe = (const float*)A.in[kv ? 20 : 17] + (size_t)l * 2048; const float* w1 = (const float*)A.in[kv ? 21 : 18] + (size_t)l * 2048 * 64 + eg * 8;
        f32x4 a0 = (f32x4){0.f, 0.f, 0.f, 0.f}, a1 = (f32x4){0.f, 0.f, 0.f, 0.f};
#pragma unroll 8
        for (int i = 0; i < 32; ++i) { const int k = C.lane * 32 + i; const float p = pe[k]; a0 = a0 + *(const f32x4*)(w1 + (size_t)k * 64) * p; a1 = a1 + *(const f32x4*)(w1 + (size_t)k * 64 + 4) * p; }
        float r[8] = {a0.x, a0.y, a0.z, a0.w, a1.x, a1.y, a1.z, a1.w};
#pragma unroll
        for (int j = 0; j < 8; ++j) r[j] = wave_sum(r[j]);
        if (C.lane == 0) { float* dst = (float*)(ws + WS_C0) + (l * 2 + kv) * 64 + eg * 8;
#pragma unroll
            for (int j = 0; j < 8; ++j) dst[j] = r[j]; } }
    { const int* pos = (const int*)A.in[1]; float* ct = (float*)(ws + WS_COS); float* st = (float*)(ws + WS_SIN);
      for (int i = C.bid * NTHR + C.tid; i < M * 8; i += C.G * NTHR) { const int m = i >> 3, k = i & 7;
          const double inv = k == 0 ? 1.0 : k == 1 ? 0.19392274474868576 : k == 2 ? 0.03760603093086393 : k == 3 ? 0.007292664737217109 : k == 4 ? 0.001414213562373095 : k == 5 ? 0.0002742481756762073 : k == 6 ? 5.318295896944988e-05 : 1.031338537721246e-05;
          const double rev = (double)pos[m] * inv * 0.15915494309189535; const float fr = (float)(rev - floor(rev));
          ct[i] = __builtin_amdgcn_cosf(fr); st[i] = __builtin_amdgcn_sinf(fr); } }
    norm_phase(C, nullptr, (const float*)A.in[0], nullptr, nullptr, (const float*)A.in[2], (bf16*)(ws + WS_XNB));
}

__device__ __forceinline__ void unpack8(const v4u w, float* f) { f[0] = bflo(w.x); f[1] = bfhi(w.x); f[2] = bflo(w.y); f[3] = bfhi(w.y); f[4] = bflo(w.z); f[5] = bfhi(w.z); f[6] = bflo(w.w); f[7] = bfhi(w.w); }

__device__ __forceinline__ void conv_unit(const Ctx& C, CA& A, int l, int u) {
    const int b = u >> 5, t0 = (u & 31) * 64, tid = C.tid;
    float* hb = (float*)C.lds;
    const bf16* Z = (const bf16*)(C.ws + WS_Z) + (size_t)b * SEQ * ZP;
    const int c = tid & 255, base = (tid >> 8) * 32;
    const float* cw = (const float*)A.in[7] + (size_t)l * 31 * 256; const float bias = ((const float*)A.in[8])[l * 256 + c];
    float w[31];
#pragma unroll
    for (int k = 0; k < 31; ++k) w[k] = cw[k * 256 + c];
    { const int c8 = (tid & 31) * 8; v4u av[6], gv4[6];
#pragma unroll
      for (int i = 0; i < 6; ++i) { const int r = (tid >> 5) + 16 * i, t = t0 - 30 + r; av[i] = (v4u){0u, 0u, 0u, 0u}; gv4[i] = (v4u){0u, 0u, 0u, 0u};
          if (r < 94 && t >= 0) { av[i] = *(const v4u*)(Z + (size_t)t * ZP + ZC_CVAL + c8); gv4[i] = *(const v4u*)(Z + (size_t)t * ZP + ZC_CGATE + c8); } }
#pragma unroll
      for (int i = 0; i < 6; ++i) { const int r = (tid >> 5) + 16 * i; float a8[8], g8[8], hv[8]; unpack8(av[i], a8); unpack8(gv4[i], g8);
#pragma unroll
          for (int j = 0; j < 8; ++j) hv[j] = a8[j] * sigmoidf_(g8[j]);
          if (r < 94) { *(f32x4*)(hb + r * 256 + c8) = (f32x4){hv[0], hv[1], hv[2], hv[3]}; *(f32x4*)(hb + r * 256 + c8 + 4) = (f32x4){hv[4], hv[5], hv[6], hv[7]}; } } }
    __syncthreads();
    float o[32];
#pragma unroll
    for (int ch = 0; ch < 4; ++ch) {
        float hv[38];
#pragma unroll
        for (int r = 0; r < 38; ++r) hv[r] = hb[(base + ch * 8 + r) * 256 + c];
#pragma unroll
        for (int i = 0; i < 8; ++i) { float acc = bias;
#pragma unroll
            for (int k = 0; k < 31; ++k) acc += w[k] * hv[i + k];
            o[ch * 8 + i] = acc; }
    }
    __syncthreads();
    float* ob = (float*)C.lds;
#pragma unroll
    for (int i = 0; i < 32; ++i) ob[(base + i) * 256 + c] = o[i];
    __syncthreads();
    const f32x4 g = *((const f32x4*)((const float*)A.in[9] + l * 256) + C.lane), bb = *((const f32x4*)((const float*)A.in[10] + l * 256) + C.lane);
    bf16* MIX = (bf16*)(C.ws + WS_MIX);
#pragma unroll 2
    for (int i = 0; i < 8; ++i) { const int tok = C.wave * 8 + i; f32x4 v = *((const f32x4*)(ob + tok * 256) + C.lane);
        const float mu = wave_sum((v.x + v.y) + (v.z + v.w)) * (1.f / 256.f); v = v - mu;
        const float var = wave_sum((v.x * v.x + v.y * v.y) + (v.z * v.z + v.w * v.w)) * (1.f / 256.f); const float rstd = 1.0f / sqrtf(var + NORM_EPS);
        f32x4 y = v * rstd * g + bb; y.x *= sigmoidf_(y.x); y.y *= sigmoidf_(y.y); y.z *= sigmoidf_(y.z); y.w *= sigmoidf_(y.w);
        v2u wv; wv.x = pk2(y.x, y.y); wv.y = pk2(y.z, y.w); *(v2u*)(MIX + (size_t)(b * SEQ + t0 + tok) * DM + MC_CONV + C.lane * 4) = wv; }
    __syncthreads();
}

__device__ __forceinline__ void pool_unit(const Ctx& C, CA& A, int l, int u) {
    const int b = u >> 5, t0 = (u & 31) * 64, tid = C.tid, lane = C.lane;
    float* pb = (float*)C.lds;
    bf16* mb = (bf16*)(C.lds + 81920);
    const bf16* Z = (const bf16*)(C.ws + WS_Z) + (size_t)b * SEQ * ZP;
    { const int c8 = (tid & 31) * 8; v4u av[5];
#pragma unroll
      for (int i = 0; i < 5; ++i) { const int r = (tid >> 5) + 16 * i, t = t0 - 15 + r; av[i] = (v4u){0u, 0u, 0u, 0u};
          if (r < 79 && t >= 0) av[i] = *(const v4u*)(Z + (size_t)t * ZP + ZC_POOL + c8); }
#pragma unroll
      for (int i = 0; i < 5; ++i) { const int r = (tid >> 5) + 16 * i; float hv[8]; unpack8(av[i], hv);
          if (r < 79) { *(f32x4*)(pb + r * 256 + c8) = (f32x4){hv[0], hv[1], hv[2], hv[3]}; *(f32x4*)(pb + r * 256 + c8 + 4) = (f32x4){hv[4], hv[5], hv[6], hv[7]}; } } }
    __syncthreads();
    { const int c = tid & 255, base = (tid >> 8) * 32, gi = c >> 6, win = 2 << gi;
      float s = 0.f; for (int k = 0; k < win; ++k) s += pb[(base + 15 - k) * 256 + c];
      for (int i = 0; i < 32; ++i) { const int tok = base + i; const float cur = pb[(tok + 15) * 256 + c];
          if (i > 0) s += cur - pb[(tok + 15 - win) * 256 + c];
          const int t = t0 + tok; const int cnt = (t + 1 < win) ? (t + 1) : win;
          mb[tok * 264 + c] = (bf16)f2bf(s / (float)cnt - cur); } }
    __syncthreads();
    { const int gi = C.wave >> 1, mt0 = (C.wave & 1) * 2, c16 = lane & 15, g = lane >> 4;
      const bf16* wT = (const bf16*)(C.ws + WS_POOLW) + (size_t)(l * 4 + gi) * 4096;
      f32x4 acc[2][4];
#pragma unroll
      for (int mi = 0; mi < 2; ++mi)
#pragma unroll
          for (int nt = 0; nt < 4; ++nt) acc[mi][nt] = (f32x4){0.f, 0.f, 0.f, 0.f};
#pragma unroll
      for (int ks = 0; ks < 2; ++ks) { bf16x8 mf[2];
#pragma unroll
          for (int mi = 0; mi < 2; ++mi) mf[mi] = *(const bf16x8*)(mb + ((mt0 + mi) * 16 + c16) * 264 + gi * 64 + ks * 32 + g * 8);
#pragma unroll
          for (int nt = 0; nt < 4; ++nt) { const bf16x8 wf = *(const bf16x8*)(wT + (nt * 16 + c16) * 64 + ks * 32 + g * 8);
#pragma unroll
              for (int mi = 0; mi < 2; ++mi) acc[mi][nt] = MFMA16(wf, mf[mi], acc[mi][nt]); } }
      const float* ps = (const float*)A.in[12] + l * 256 + gi * 64; bf16* MIX = (bf16*)(C.ws + WS_MIX);
#pragma unroll
      for (int mi = 0; mi < 2; ++mi)
#pragma unroll
          for (int nt = 0; nt < 4; ++nt) { const int tok = (mt0 + mi) * 16 + c16, d = nt * 16 + g * 4; const f32x4 sc = *(const f32x4*)(ps + d); const f32x4 o = acc[mi][nt] * sc;
              v2u wv; wv.x = pk2(o.x, o.y); wv.y = pk2(o.z, o.w); *(v2u*)(MIX + (size_t)(b * SEQ + t0 + tok) * DM + MC_POOL + gi * 64 + d) = wv; } }
    __syncthreads();
}

__device__ __forceinline__ void sgu_unit(const Ctx& C, CA& A, int l, int u) {
    const int b = u >> 5, ck = (u & 31) >> 1, hp = u & 1, t0 = ck * 128, lane = C.lane, w = C.wave;
    bf16* vT = (bf16*)C.lds;
    const bf16* Z = (const bf16*)(C.ws + WS_Z) + (size_t)(b * SEQ + t0) * ZP;
    { const f32x4 g = *((const f32x4*)((const float*)A.in[13] + l * 256) + lane), bb = *((const f32x4*)((const float*)A.in[14] + l * 256) + lane);
      v2u rawv[16];
#pragma unroll
      for (int i = 0; i < 16; ++i) rawv[i] = *(const v2u*)(Z + (size_t)(w * 16 + i) * ZP + ZC_SV + lane * 4);
#pragma unroll
      for (int i = 0; i < 16; ++i) { const int tok = w * 16 + i; const v2u raw = rawv[i];
          f32x4 v = (f32x4){gelu_tanh(bflo(raw.x)), gelu_tanh(bfhi(raw.x)), gelu_tanh(bflo(raw.y)), gelu_tanh(bfhi(raw.y))};
          const float mu = wave_sum((v.x + v.y) + (v.z + v.w)) * (1.f / 256.f); v = v - mu;
          const float var = wave_sum((v.x * v.x + v.y * v.y) + (v.z * v.z + v.w * v.w)) * (1.f / 256.f); const float rstd = 1.0f / sqrtf(var + NORM_EPS);
          const f32x4 y = v * rstd * g + bb;
          if ((lane >> 5) == hp) { const int cl = (lane & 31) * 4; vT[(cl + 0) * 136 + tok] = (bf16)f2bf(y.x); vT[(cl + 1) * 136 + tok] = (bf16)f2bf(y.y); vT[(cl + 2) * 136 + tok] = (bf16)f2bf(y.z); vT[(cl + 3) * 136 + tok] = (bf16)f2bf(y.w); } } }
    __syncthreads();
    { const int c16 = lane & 15, g = lane >> 4, nks = ((16 * w + 15) >> 5) + 1, tok = w * 16 + c16;
      bf16* MIX = (bf16*)(C.ws + WS_MIX);
      v2u uraw[2][4];
#pragma unroll
      for (int hh = 0; hh < 2; ++hh)
#pragma unroll
          for (int dt = 0; dt < 4; ++dt) uraw[hh][dt] = *(const v2u*)(Z + (size_t)tok * ZP + ZC_SU + (hp * 2 + hh) * 64 + dt * 16 + g * 4);
#pragma unroll
      for (int hh = 0; hh < 2; ++hh) { const int h = hp * 2 + hh; const bf16* Wh = (const bf16*)(C.ws + WS_SGUW) + (size_t)(l * 4 + h) * 128 * 128;
          f32x4 acc[4];
#pragma unroll
          for (int dt = 0; dt < 4; ++dt) acc[dt] = (f32x4){0.f, 0.f, 0.f, 0.f};
#pragma unroll
          for (int ks = 0; ks < 4; ++ks) if (ks < nks) { const bf16x8 wf = *(const bf16x8*)(Wh + (size_t)tok * 128 + ks * 32 + g * 8);
#pragma unroll
              for (int dt = 0; dt < 4; ++dt) { const bf16x8 vf = *(const bf16x8*)(vT + (hh * 64 + dt * 16 + c16) * 136 + ks * 32 + g * 8); acc[dt] = MFMA16(vf, wf, acc[dt]); } }
          const float bias = ((const float*)A.in[16])[(l * 4 + h) * 128 + tok];
#pragma unroll
          for (int dt = 0; dt < 4; ++dt) { const int d = dt * 16 + g * 4; const v2u raw = uraw[hh][dt];
              const float o0 = gelu_tanh(bflo(raw.x)) * (acc[dt][0] + bias), o1 = gelu_tanh(bfhi(raw.x)) * (acc[dt][1] + bias), o2 = gelu_tanh(bflo(raw.y)) * (acc[dt][2] + bias), o3 = gelu_tanh(bfhi(raw.y)) * (acc[dt][3] + bias);
              v2u wv; wv.x = pk2(o0, o1); wv.y = pk2(o2, o3); *(v2u*)(MIX + (size_t)(b * SEQ + t0 + tok) * DM + MC_SGU + h * 64 + d) = wv; } } }
    __syncthreads();
}

__device__ __forceinline__ void cmp_unit(const Ctx& C, CA& A, int l, int u) {
    const int b = u >> 4, kv = (u >> 3) & 1, nt = u & 7, lane = C.lane, w = C.wave, tid = C.tid;
    const int c16 = lane & 15, g = lane >> 4, n = nt * 16 + c16;
    const bf16* Z = (const bf16*)(C.ws + WS_Z) + (size_t)b * SEQ * ZP + (kv ? ZC_VC : ZC_KC);
    const bf16* W1T = (const bf16*)(C.ws + WS_CW1) + (size_t)(l * 2 + kv) * 64 * 2048;
    f32x4 acc[4];
#pragma unroll
    for (int et = 0; et < 4; ++et) acc[et] = (f32x4){0.f, 0.f, 0.f, 0.f};
#pragma unroll
    for (int i = 0; i < 8; ++i) { const int ll = 4 * w + (i >> 1), d0 = (i & 1) * 32;
        bf16x8 xf = (bf16x8){0, 0, 0, 0, 0, 0, 0, 0};
        if (n < 127) xf = *(const bf16x8*)(Z + (size_t)(16 * n + ll) * ZP + d0 + g * 8);
#pragma unroll
        for (int et = 0; et < 4; ++et) { const bf16x8 wf = *(const bf16x8*)(W1T + (size_t)(et * 16 + c16) * 2048 + ll * 64 + d0 + g * 8); acc[et] = MFMA16(wf, xf, acc[et]); } }
    float* red = (float*)C.lds;
    float* hid = (float*)(C.lds + 34816);
    float* ob = (float*)(C.lds + 34816 + 4160);
    float* w2s = (float*)(C.lds + 49152);
    { const float* w2 = (const float*)A.in[kv ? 22 : 19] + (size_t)l * 4096; const f32x4 wa = *((const f32x4*)w2 + tid), wb = *((const f32x4*)w2 + 512 + tid); *((f32x4*)w2s + tid) = wa; *((f32x4*)w2s + 512 + tid) = wb; }
#pragma unroll
    for (int et = 0; et < 4; ++et)
#pragma unroll
        for (int j = 0; j < 4; ++j) red[(w * 64 + et * 16 + g * 4 + j) * 17 + c16] = acc[et][j];
    __syncthreads();
    const float* c0 = (const float*)(C.ws + WS_C0) + (l * 2 + kv) * 64;
#pragma unroll
    for (int q = 0; q < 2; ++q) { const int idx = tid + 512 * q, e = idx & 63, nl = idx >> 6; float s = c0[e];
#pragma unroll
        for (int ww = 0; ww < 8; ++ww) s += red[(ww * 64 + e) * 17 + nl];
        hid[nl * 65 + e] = gelu_tanh(s); }
    __syncthreads();
    const int nl = tid >> 5, e2 = (tid & 31) * 2;
    { float o0 = 0.f, o1 = 0.f;
#pragma unroll 8
      for (int e = 0; e < 64; ++e) { const float hv = hid[nl * 65 + e]; const f32x2 wv = *(const f32x2*)(w2s + e * 64 + e2); o0 += hv * wv.x; o1 += hv * wv.y; }
      ob[nl * 64 + e2] = o0; ob[nl * 64 + e2 + 1] = o1; }
    __syncthreads();
    { const int nn = nt * 16 + nl; float v0 = ob[nl * 64 + e2], v1 = ob[nl * 64 + e2 + 1];
      if (nn >= 127) { v0 = 0.f; v1 = 0.f; }
      else if (kv == 0 && e2 < 16) { const size_t tr = (size_t)(b * SEQ + 16 * nn + 31) * 8; const float* ct = (const float*)(C.ws + WS_COS) + tr; const float* st = (const float*)(C.ws + WS_SIN) + tr;
#pragma unroll
          for (int q = 0; q < 2; ++q) { const int e = e2 + q, i = e & 7; const float x1 = ob[nl * 64 + i], x2 = ob[nl * 64 + i + 8], cc = ct[i], ss = st[i];
              const float r = (e < 8) ? (x1 * cc - x2 * ss) : (x2 * cc + x1 * ss); if (q == 0) v0 = r; else v1 = r; } }
      bf16* dst = (bf16*)(C.ws + (kv ? WS_VCMP : WS_KCMP)) + (size_t)(b * 128 + nn) * 64 + e2;
      *(unsigned*)dst = pk2(v0, v1); }
    __syncthreads();
}

__device__ __forceinline__ void rope_pass(const Ctx& C) {
    bf16* Z = (bf16*)(C.ws + WS_Z); const float* ct = (const float*)(C.ws + WS_COS); const float* st = (const float*)(C.ws + WS_SIN);
    for (int idx = C.bid * NTHR + C.tid; idx < M * 6; idx += C.G * NTHR) { const int m = idx / 6, vec = idx - m * 6;
        const int col = vec < 4 ? ZC_Q + vec * 64 : (vec == 4 ? ZC_KS : ZC_KW);
        bf16* p = Z + (size_t)m * ZP + col; const v4u a = *(const v4u*)p, bq = *(const v4u*)(p + 8); float x1[8], x2[8], cc[8], ss[8]; unpack8(a, x1); unpack8(bq, x2);
        { const f32x4 c0 = *(const f32x4*)(ct + (size_t)m * 8), c1 = *(const f32x4*)(ct + (size_t)m * 8 + 4), s0 = *(const f32x4*)(st + (size_t)m * 8), s1 = *(const f32x4*)(st + (size_t)m * 8 + 4);
          cc[0] = c0.x; cc[1] = c0.y; cc[2] = c0.z; cc[3] = c0.w; cc[4] = c1.x; cc[5] = c1.y; cc[6] = c1.z; cc[7] = c1.w; ss[0] = s0.x; ss[1] = s0.y; ss[2] = s0.z; ss[3] = s0.w; ss[4] = s1.x; ss[5] = s1.y; ss[6] = s1.z; ss[7] = s1.w; }
        float y1[8], y2[8];
#pragma unroll
        for (int i = 0; i < 8; ++i) { y1[i] = x1[i] * cc[i] - x2[i] * ss[i]; y2[i] = x2[i] * cc[i] + x1[i] * ss[i]; }
        v4u o1, o2; o1.x = pk2(y1[0], y1[1]); o1.y = pk2(y1[2], y1[3]); o1.z = pk2(y1[4], y1[5]); o1.w = pk2(y1[6], y1[7]); o2.x = pk2(y2[0], y2[1]); o2.y = pk2(y2[2], y2[3]); o2.z = pk2(y2[4], y2[5]); o2.w = pk2(y2[6], y2[7]);
        *(v4u*)p = o1; *(v4u*)(p + 8) = o2; }
}

__device__ __forceinline__ int opaque(int v) { asm volatile("" : "+v"(v)); return v; }
constexpr float SM_C = 0.18033688011112042f;
constexpr float NEG_BIG = -1.0e30f;
constexpr int KV_PITCH = 72;
constexpr int A_KV = 0, KVBUF_BYTES = 2 * 64 * KV_PITCH * 2  ;
constexpr int A_KC = 2 * KVBUF_BYTES  , A_VCT = A_KC + 128 * KV_PITCH * 2  , VCT_PITCH = 136;
constexpr int A_IMP = A_VCT + 64 * VCT_PITCH * 2  , A_VAL = A_IMP + 4 * 64 * 33 * 4  , A_SEL = A_VAL + 64 * 33 * 4  , A_BL = A_SEL + 256, A_END3 = A_BL + 256;
static_assert(A_END3 <= 131072, "P3 LDS map");

typedef float f32x2_t __attribute__((ext_vector_type(2))); typedef __bf16 bf16x2_t __attribute__((ext_vector_type(2)));
__device__ __forceinline__ unsigned cvtpk(float lo, float hi) { f32x2_t v = {lo, hi}; bf16x2_t b = __builtin_convertvector(v, bf16x2_t); return __builtin_bit_cast(unsigned, b); }
constexpr float M_INIT = -1.0e29f;
template <int MODE>
__device__ __forceinline__ void attn_block(const bf16* Ks, const bf16* Vt, const bf16x8 (&qf)[2][2], f32x4 (&O)[2][4], float (&mrun)[2], float (&lpart)[2], const int (&lo)[2], const int (&hi)[2], const bool (&selok)[2], int c16, int g) {
    f32x4 sc[2][4];
#pragma unroll
    for (int kt = 0; kt < 4; ++kt) { const bf16x8 k0 = *(const bf16x8*)(Ks + (kt * 16 + c16) * KV_PITCH + g * 8), k1 = *(const bf16x8*)(Ks + (kt * 16 + c16) * KV_PITCH + 32 + g * 8);
#pragma unroll
        for (int s = 0; s < 2; ++s) { sc[s][kt] = MFMA16(k0, qf[s][0], ((f32x4){0.f, 0.f, 0.f, 0.f})); sc[s][kt] = MFMA16(k1, qf[s][1], sc[s][kt]); } }
#pragma unroll
    for (int s = 0; s < 2; ++s) {
        float mx = NEG_BIG;
#pragma unroll
        for (int kt = 0; kt < 4; ++kt)
#pragma unroll
            for (int j = 0; j < 4; ++j) { float v = sc[s][kt][j];
                if (MODE == 1) v = selok[s] ? v : NEG_BIG;
                if (MODE == 2) v = ((kt * 16 + j >= lo[s]) && (kt * 16 + j <= hi[s])) ? v : NEG_BIG;
                sc[s][kt][j] = v; mx = fmaxf(mx, v); }
        if (__any(mx * SM_C > mrun[s] + 8.0f)) {
            mx = fmaxf(mx, __shfl_xor(mx, 16)); mx = fmaxf(mx, __shfl_xor(mx, 32));
            const float mnew = fmaxf(mrun[s], mx * SM_C); const float alpha = __builtin_amdgcn_exp2f(mrun[s] - mnew);
            lpart[s] *= alpha; mrun[s] = mnew;
#pragma unroll
            for (int dt = 0; dt < 4; ++dt) O[s][dt] = O[s][dt] * alpha;
        }
        const float nm = -mrun[s]; float ps = 0.f;
#pragma unroll
        for (int kt = 0; kt < 4; ++kt)
#pragma unroll
            for (int j = 0; j < 4; ++j) { const float p = __builtin_amdgcn_exp2f(__builtin_fmaf(sc[s][kt][j], SM_C, nm)); sc[s][kt][j] = p; ps += p; }
        lpart[s] += ps;
    }
#pragma unroll
    for (int kk = 0; kk < 2; ++kk) { bf16x8 pf[2];
#pragma unroll
        for (int s = 0; s < 2; ++s) { const f32x4 a = sc[s][2 * kk], bq = sc[s][2 * kk + 1]; v4u t; t.x = cvtpk(a[0], a[1]); t.y = cvtpk(a[2], a[3]); t.z = cvtpk(bq[0], bq[1]); t.w = cvtpk(bq[2], bq[3]); pf[s] = __builtin_bit_cast(bf16x8, t); }
#pragma unroll
        for (int dt = 0; dt < 4; ++dt) { const bf16* vp = Vt + (dt * 16 + c16) * KV_PITCH + (2 * kk) * 16 + g * 4; const v2u v0 = *(const v2u*)vp, v1 = *(const v2u*)(vp + 16);
            v4u t; t.x = v0.x; t.y = v0.y; t.z = v1.x; t.w = v1.y; const bf16x8 vf = __builtin_bit_cast(bf16x8, t);
#pragma unroll
            for (int s = 0; s < 2; ++s) O[s][dt] = MFMA16(vf, pf[s], O[s][dt]); } }
}

__device__ __forceinline__ void attn_branch(const Ctx& C, const bf16* Zb, int type, int nb, int qb, const bf16x8 (&qf)[2][2], const float (&gate)[2], f32x4 (&out)[2][4], int th) {
    const int tid = opaque(C.tid), lane = tid & 63, c16 = lane & 15, g = lane >> 4;
    const int* bl = (const int*)(C.lds + A_BL); const unsigned* selm = (const unsigned*)(C.lds + A_SEL);
    const int kcol = type ? ZC_KS : ZC_KW, vcol = type ? ZC_VS : ZC_VW;
    const int skey = tid >> 3, soct = tid & 7;
    f32x4 O[2][4]; float mrun[2], lpart[2];
#pragma unroll
    for (int s = 0; s < 2; ++s) { mrun[s] = M_INIT; lpart[s] = 0.f;
#pragma unroll
        for (int dt = 0; dt < 4; ++dt) O[s][dt] = (f32x4){0.f, 0.f, 0.f, 0.f}; }
    unsigned sm[2]; sm[0] = selm[th * 32 + c16]; sm[1] = selm[th * 32 + 16 + c16];
    v4u kreg, vreg;
#define STAGE_KV(Kd, Vd) do { *(v4u*)((Kd) + skey * KV_PITCH + soct * 8) = kreg; \
        (Vd)[(soct * 8 + 0) * KV_PITCH + skey] = (bf16)(vreg.x & 0xffff); (Vd)[(soct * 8 + 1) * KV_PITCH + skey] = (bf16)(vreg.x >> 16); (Vd)[(soct * 8 + 2) * KV_PITCH + skey] = (bf16)(vreg.y & 0xffff); (Vd)[(soct * 8 + 3) * KV_PITCH + skey] = (bf16)(vreg.y >> 16); \
        (Vd)[(soct * 8 + 4) * KV_PITCH + skey] = (bf16)(vreg.z & 0xffff); (Vd)[(soct * 8 + 5) * KV_PITCH + skey] = (bf16)(vreg.z >> 16); (Vd)[(soct * 8 + 6) * KV_PITCH + skey] = (bf16)(vreg.w & 0xffff); (Vd)[(soct * 8 + 7) * KV_PITCH + skey] = (bf16)(vreg.w >> 16); } while (0)
    if (nb > 0) { const int J = bl[0]; const bf16* src = Zb + (size_t)(J * 64 + skey) * ZP + soct * 8; kreg = *(const v4u*)(src + kcol); vreg = *(const v4u*)(src + vcol);
        bf16* Ks = (bf16*)(C.lds + A_KV); bf16* Vt = Ks + 64 * KV_PITCH; STAGE_KV(Ks, Vt); }
    __syncthreads();
    for (int i = 0; i < nb; ++i) {
        const int J = bl[i];
        if (i + 1 < nb) { const int Jn = bl[i + 1]; const bf16* src = Zb + (size_t)(Jn * 64 + skey) * ZP + soct * 8; kreg = *(const v4u*)(src + kcol); vreg = *(const v4u*)(src + vcol); }
        const bf16* Ks = (const bf16*)(C.lds + A_KV + (i & 1) * KVBUF_BYTES); const bf16* Vt = Ks + 64 * KV_PITCH;
        int lo[2], hi[2]; bool selok[2]; const int rel = qb - J;
#pragma unroll
        for (int s = 0; s < 2; ++s) { const int qo = th * 32 + s * 16 + c16; const bool sel = (type == 0) || ((sm[s] >> J) & 1u); selok[s] = sel;
            lo[s] = sel ? ((type == 0 && rel == 8) ? qo + 1 : 0) : 200; hi[s] = sel ? ((rel == 0) ? qo : 63) : -200;
            lo[s] -= 4 * g; hi[s] -= 4 * g; }
        if (rel == 0 || (type == 0 && rel == 8)) attn_block<2>(Ks, Vt, qf, O, mrun, lpart, lo, hi, selok, c16, g);
        else if (type == 0) attn_block<0>(Ks, Vt, qf, O, mrun, lpart, lo, hi, selok, c16, g);
        else attn_block<1>(Ks, Vt, qf, O, mrun, lpart, lo, hi, selok, c16, g);
        if (i + 1 < nb) { bf16* Kn = (bf16*)(C.lds + A_KV + ((i + 1) & 1) * KVBUF_BYTES); bf16* Vn = Kn + 64 * KV_PITCH; STAGE_KV(Kn, Vn); }
        __syncthreads();
    }
#undef STAGE_KV
#pragma unroll
    for (int s = 0; s < 2; ++s) { float l = lpart[s]; l += __shfl_xor(l, 16); l += __shfl_xor(l, 32); const float f = l > 0.f ? gate[s] / l : 0.f;
#pragma unroll
        for (int dt = 0; dt < 4; ++dt) out[s][dt] = out[s][dt] + O[s][dt] * f; }
}

__device__ __forceinline__ void nsa_unit(const Ctx& C, int u) {
    const int b = u >> 5, qb = u & 31, t0 = qb * 64, tid = opaque(C.tid), lane = tid & 63, w = __builtin_amdgcn_readfirstlane(tid >> 6);
    const int h = w >> 1, th = w & 1, c16 = lane & 15, g = lane >> 4;
    const bf16* Zb = (const bf16*)(C.ws + WS_Z) + (size_t)b * SEQ * ZP;
    unsigned char* lds = C.lds;
    { const bf16* kc = (const bf16*)(C.ws + WS_KCMP) + (size_t)b * 128 * 64; const bf16* vc = (const bf16*)(C.ws + WS_VCMP) + (size_t)b * 128 * 64;
      bf16* Kc = (bf16*)(lds + A_KC); bf16* Vct = (bf16*)(lds + A_VCT);
#pragma unroll
      for (int q = 0; q < 2; ++q) { const int idx = opaque(tid) + 512 * q, key = idx >> 3, oct = idx & 7;
          const v4u kr = *(const v4u*)(kc + key * 64 + oct * 8), vr = *(const v4u*)(vc + key * 64 + oct * 8);
          *(v4u*)(Kc + key * KV_PITCH + oct * 8) = kr;
          Vct[(oct * 8 + 0) * VCT_PITCH + key] = (bf16)(vr.x & 0xffff); Vct[(oct * 8 + 1) * VCT_PITCH + key] = (bf16)(vr.x >> 16); Vct[(oct * 8 + 2) * VCT_PITCH + key] = (bf16)(vr.y & 0xffff); Vct[(oct * 8 + 3) * VCT_PITCH + key] = (bf16)(vr.y >> 16);
          Vct[(oct * 8 + 4) * VCT_PITCH + key] = (bf16)(vr.z & 0xffff); Vct[(oct * 8 + 5) * VCT_PITCH + key] = (bf16)(vr.z >> 16); Vct[(oct * 8 + 6) * VCT_PITCH + key] = (bf16)(vr.w & 0xffff); Vct[(oct * 8 + 7) * VCT_PITCH + key] = (bf16)(vr.w >> 16); }
      if (tid < 64) ((unsigned*)(lds + A_SEL))[tid] = 0u;
      const int jw0 = qb >= 8 ? qb - 8 : 0; if (tid < 16) ((int*)(lds + A_BL))[tid] = jw0 + tid; }
    bf16x8 qf[2][2]; float gt[2][3];
#pragma unroll
    for (int s = 0; s < 2; ++s) { const bf16* qrow = Zb + (size_t)(t0 + th * 32 + s * 16 + c16) * ZP;
        qf[s][0] = *(const bf16x8*)(qrow + ZC_Q + h * 64 + g * 8); qf[s][1] = *(const bf16x8*)(qrow + ZC_Q + h * 64 + 32 + g * 8);
#pragma unroll
        for (int br = 0; br < 3; ++br) { const unsigned short raw = qrow[ZC_G + h * 3 + br]; gt[s][br] = sigmoidf_(bflo((unsigned)raw)); } }
    f32x4 out[2][4];
#pragma unroll
    for (int s = 0; s < 2; ++s)
#pragma unroll
        for (int dt = 0; dt < 4; ++dt) out[s][dt] = (f32x4){0.f, 0.f, 0.f, 0.f};
    __syncthreads();
    { const bf16* Kc = (const bf16*)(lds + A_KC); const bf16* Vct = (const bf16*)(lds + A_VCT); float* imp = (float*)(lds + A_IMP);
      const int nkt = ((4 * qb + 2) >> 4) + 1;
      f32x4 sc[2][8];
#pragma unroll
      for (int kt = 0; kt < 8; ++kt) {
#pragma unroll
          for (int s = 0; s < 2; ++s) sc[s][kt] = (f32x4){0.f, 0.f, 0.f, 0.f};
          if (kt < nkt) { const bf16x8 k0 = *(const bf16x8*)(Kc + (kt * 16 + c16) * KV_PITCH + g * 8), k1 = *(const bf16x8*)(Kc + (kt * 16 + c16) * KV_PITCH + 32 + g * 8);
#pragma unroll
              for (int s = 0; s < 2; ++s) { sc[s][kt] = MFMA16(k0, qf[s][0], sc[s][kt]); sc[s][kt] = MFMA16(k1, qf[s][1], sc[s][kt]); } } }
#pragma unroll
      for (int s = 0; s < 2; ++s) { const int t = t0 + th * 32 + s * 16 + c16; const int nrel = ((t >= 31) ? ((t - 31) >> 4) : -1) - 4 * g;
          float mx = NEG_BIG;
#pragma unroll
          for (int kt = 0; kt < 8; ++kt)
#pragma unroll
              for (int j = 0; j < 4; ++j) { const float v = (kt * 16 + j <= nrel) ? sc[s][kt][j] * SM_C : NEG_BIG; sc[s][kt][j] = v; mx = fmaxf(mx, v); }
          mx = fmaxf(mx, __shfl_xor(mx, 16)); mx = fmaxf(mx, __shfl_xor(mx, 32));
          float ps = 0.f;
#pragma unroll
          for (int kt = 0; kt < 8; ++kt)
#pragma unroll
              for (int j = 0; j < 4; ++j) { const float v = sc[s][kt][j]; const float p = (v > -1.0e29f) ? __builtin_amdgcn_exp2f(v - mx) : 0.f; sc[s][kt][j] = p; ps += p; }
          ps += __shfl_xor(ps, 16); ps += __shfl_xor(ps, 32);
          const float inv = ps > 0.f ? 1.0f / ps : 0.f;
#pragma unroll
          for (int kt = 0; kt < 8; ++kt) sc[s][kt] = sc[s][kt] * inv;
          float* irow = imp + (h * 64 + th * 32 + s * 16 + c16) * 33;
          float cprev = 0.f;
#pragma unroll
          for (int kt = 0; kt < 8; ++kt) { const f32x4 p = sc[s][kt]; const float a = 2.f * (p[0] + p[1] + p[2]) + p[3];
              const float up = __shfl(p[3], (lane + 48) & 63);
              const float pv = (g > 0) ? up : cprev; cprev = up;
              irow[kt * 4 + g] = a + pv; }
      }
      f32x4 O[2][4];
#pragma unroll
      for (int s = 0; s < 2; ++s)
#pragma unroll
          for (int dt = 0; dt < 4; ++dt) O[s][dt] = (f32x4){0.f, 0.f, 0.f, 0.f};
#pragma unroll
      for (int kk = 0; kk < 4; ++kk) if (2 * kk < nkt) { bf16x8 pf[2];
#pragma unroll
          for (int s = 0; s < 2; ++s) { const f32x4 a = sc[s][2 * kk], bq = sc[s][2 * kk + 1]; v4u t; t.x = cvtpk(a[0], a[1]); t.y = cvtpk(a[2], a[3]); t.z = cvtpk(bq[0], bq[1]); t.w = cvtpk(bq[2], bq[3]); pf[s] = __builtin_bit_cast(bf16x8, t); }
#pragma unroll
          for (int dt = 0; dt < 4; ++dt) { const bf16* vp = Vct + (dt * 16 + c16) * VCT_PITCH + (2 * kk) * 16 + g * 4; const v2u v0 = *(const v2u*)vp, v1 = *(const v2u*)(vp + 16);
              v4u t; t.x = v0.x; t.y = v0.y; t.z = v1.x; t.w = v1.y; const bf16x8 vf = __builtin_bit_cast(bf16x8, t);
#pragma unroll
              for (int s = 0; s < 2; ++s) O[s][dt] = MFMA16(vf, pf[s], O[s][dt]); } }
#pragma unroll
      for (int s = 0; s < 2; ++s)
#pragma unroll
          for (int dt = 0; dt < 4; ++dt) out[s][dt] = O[s][dt] * gt[s][0];
    }
    __syncthreads();
    { const float* imp = (const float*)(lds + A_IMP); float* val = (float*)(lds + A_VAL);
#pragma unroll
      for (int q = 0; q < 4; ++q) { const int idx = opaque(tid) + 512 * q, tok = idx >> 5, J = idx & 31; const int back = qb - J;
          float v = ((imp[(0 * 64 + tok) * 33 + J] + imp[(1 * 64 + tok) * 33 + J]) + imp[(2 * 64 + tok) * 33 + J]) + imp[(3 * 64 + tok) * 33 + J];
          if (J == 0 || (back >= 0 && back < 2)) v = 1.0e9f; else if (back < 0) v = -1.0f;
          val[tok * 33 + J] = v; } }
    __syncthreads();
    { const float* val = (const float*)(lds + A_VAL); unsigned* selm = (unsigned*)(lds + A_SEL);
#pragma unroll
      for (int q = 0; q < 4; ++q) { const int idx = opaque(tid) + 512 * q, tok = idx >> 5, J = idx & 31; const float v = val[tok * 33 + J]; int rank = 0;
          for (int j2 = 0; j2 < 32; ++j2) { const float o = val[tok * 33 + j2]; rank += (o > v || (o == v && j2 < J)) ? 1 : 0; }
          if (J <= qb && rank < 8) atomicOr(&selm[tok], 1u << J); } }
    __syncthreads();
    { const int nwin = qb >= 8 ? 9 : qb + 1; float gate[2] = {gt[0][2], gt[1][2]};
      attn_branch(C, Zb, 0, nwin, qb, qf, gate, out, th); }
    { const unsigned* selm = (const unsigned*)(lds + A_SEL); unsigned um = selm[lane];
#pragma unroll
      for (int o = 1; o < 64; o <<= 1) um |= (unsigned)__shfl_xor((int)um, o);
      um = (unsigned)__builtin_amdgcn_readfirstlane((int)um);
      const int nslc = __builtin_popcount(um);
      if (tid == 0) { int* bl = (int*)(lds + A_BL); unsigned r = um; int k = 0; while (r) { const int J = __builtin_ctz(r); r &= r - 1; bl[k++] = J; } }
      __syncthreads();
      float gate[2] = {gt[0][1], gt[1][1]};
      attn_branch(C, Zb, 1, nslc, qb, qf, gate, out, th); }
    { bf16* MIX = (bf16*)(C.ws + WS_MIX); const int lz = opaque(lane), c16 = lz & 15, g = lz >> 4;
#pragma unroll
      for (int s = 0; s < 2; ++s) { bf16* orow = MIX + (size_t)(b * SEQ + t0 + th * 32 + s * 16 + c16) * DM + MC_NSA + h * 64;
#pragma unroll
          for (int dt = 0; dt < 4; ++dt) { const f32x4 o = out[s][dt]; v2u wv; wv.x = pk2(o[0], o[1]); wv.y = pk2(o[2], o[3]); *(v2u*)(orow + dt * 16 + g * 4) = wv; } } }
    __syncthreads();
}

#ifndef REP_P2
#define REP_P2 1
#endif
#ifndef REP_P3
#define REP_P3 1
#endif
#ifndef REP_G
#define REP_G 1
#endif
constexpr int N_PHASES = 1 + DEPTH * 8;
__global__ void __launch_bounds__(NTHR, 2) hybrid_fwd(Args args) {
    extern __shared__ __attribute__((aligned(16))) unsigned char lds[];
    Ctx C; C.lds = lds; C.ws = ARGS.ws; C.tid = threadIdx.x; C.lane = C.tid & 63; C.wave = __builtin_amdgcn_readfirstlane(C.tid >> 6); C.G = gridDim.x; C.bid = blockIdx.x;
    const int lo = ARGS.ph_lo, hi = ARGS.ph_hi;
    if (C.tid < 64) ((LAS unsigned*)(LAS unsigned char*)lds)[(LDS_CTL_OFF >> 2) + C.tid] = 0u;
    __syncthreads();
    const XcdBarrier bar = xcd_barrier_post((unsigned*)C.ws, (volatile LAS unsigned*)((LAS unsigned char*)lds + LDS_CTL_OFF));
    int ph = 0;
#define IN(k) (lo <= (k) && (k) < hi)
#define SEAM(k) do { if (IN(k) && IN((k) + 1)) { if ((k) == 0) cg::this_grid().sync(); else xcd_barrier(bar); } } while (0)

#ifndef NO_P0
    if (IN(0)) { const Ctx Cp = fresh(C); p0_prologue(Cp, ARGS); }
#endif

    SEAM(0);
    _Pragma("unroll") for (int l = 0; l < DEPTH; ++l) {
        ph = 1 + l * 8;

        if (IN(ph)) for (int rep_ = 0; rep_ < REP_G; ++rep_) { if (rep_) xcd_barrier(bar); const Ctx Cp = fresh(C); unsigned char* ws = Cp.ws; pg8::Gemm g{(const pg8::bf16_t*)(ws + WS_XNB), (const pg8::bf16_t*)(ws + WS_WIN) + (size_t)l * ZP * DM, M, ZP, DM}; pg8::StaticOrder S; S.init(M, ZP, Cp.G, Cp.bid);
            pg8::EpiBf16<0> E{(pg8::bf16_t*)(ws + WS_Z), ZP};
            pg8::gemm_phase<pg8::EpiBf16<0>, pg8::StaticOrder, true, true>((LAS unsigned char*)lds, g, S, E); }
        SEAM(ph); ++ph;
        if (IN(ph)) {
            for (int rep_ = 0; rep_ < REP_P2; ++rep_) { if (rep_) xcd_barrier(bar);
            const Ctx Cp = fresh(C);
#ifndef NO_CONV
            for (int u = Cp.bid; u < 256; u += Cp.G) conv_unit(Cp, ARGS, l, u);
#endif


#ifndef NO_POOL
            for (int u = Cp.bid; u < 256; u += Cp.G) pool_unit(Cp, ARGS, l, u);
#endif


#ifndef NO_SGU
            for (int u = Cp.bid; u < 256; u += Cp.G) sgu_unit(Cp, ARGS, l, u);
#endif


#ifndef NO_CMP
            for (int u = Cp.G - 1 - Cp.bid; u < 128; u += Cp.G) cmp_unit(Cp, ARGS, l, u);
#endif


#ifndef NO_ROPE
            if (rep_ == 0) rope_pass(Cp);
#endif
            }

        }
        SEAM(ph); ++ph;

#ifndef NO_NSA
        if (IN(ph)) for (int rep_ = 0; rep_ < REP_P3; ++rep_) { if (rep_) xcd_barrier(bar); const Ctx Cp = fresh(C); for (int u = Cp.G - 1 - Cp.bid; u >= 0 && u < 256; u += Cp.G) nsa_unit(Cp, u); }
#endif

        SEAM(ph); ++ph;
        if (IN(ph)) for (int rep_ = 0; rep_ < REP_G; ++rep_) { if (rep_) xcd_barrier(bar); const Ctx Cp = fresh(C); unsigned char* ws = Cp.ws; pg8::Gemm g{(const pg8::bf16_t*)(ws + WS_MIX), (const pg8::bf16_t*)(ws + WS_WOUT) + (size_t)l * DM * DM, M, DM, DM}; pg8::StaticOrder S; S.init(M, DM, Cp.G, Cp.bid);
            pg8::EpiF32 E{(float*)(ws + WS_Y1), DM};
            pg8::gemm_phase<pg8::EpiF32, pg8::StaticOrder, true, true>((LAS unsigned char*)lds, g, S, E); }
        SEAM(ph); ++ph;
        if (IN(ph)) { CA& A = ARGS; const Ctx Cp = fresh(C); norm_phase(Cp, (const float*)(Cp.ws + WS_Y1), (l == 0) ? (const float*)A.in[0] : (const float*)A.out, A.out, (const float*)A.in[3] + l * DM, (const float*)A.in[4] + l * DM, (bf16*)(Cp.ws + WS_XNA)); }
        SEAM(ph); ++ph;
        if (IN(ph)) for (int rep_ = 0; rep_ < REP_G; ++rep_) { if (rep_) xcd_barrier(bar); const Ctx Cp = fresh(C); unsigned char* ws = Cp.ws; pg8::Gemm g{(const pg8::bf16_t*)(ws + WS_XNA), (const pg8::bf16_t*)(ws + WS_W1) + (size_t)l * FF * DM, M, FF, DM}; pg8::StaticOrder S; S.init(M, FF, Cp.G, Cp.bid);
            pg8::EpiBf16<2> E{(pg8::bf16_t*)(ws + WS_F), FF};
            pg8::gemm_phase<pg8::EpiBf16<2>, pg8::StaticOrder, true, true>((LAS unsigned char*)lds, g, S, E); }
        SEAM(ph); ++ph;
        if (IN(ph)) for (int rep_ = 0; rep_ < REP_G; ++rep_) { if (rep_) xcd_barrier(bar); const Ctx Cp = fresh(C); unsigned char* ws = Cp.ws; pg8::Gemm g{(const pg8::bf16_t*)(ws + WS_F), (const pg8::bf16_t*)(ws + WS_W2) + (size_t)l * DM * FF, M, DM, FF}; pg8::StaticOrder S; S.init(M, DM, Cp.G, Cp.bid);
            pg8::EpiF32 E{(float*)(ws + WS_Y2), DM};
            pg8::gemm_phase<pg8::EpiF32, pg8::StaticOrder, true, true>((LAS unsigned char*)lds, g, S, E); }
        SEAM(ph); ++ph;
        if (IN(ph)) { CA& A = ARGS; const Ctx Cp = fresh(C); norm_phase(Cp, (const float*)(Cp.ws + WS_Y2), A.out, A.out, (const float*)A.in[5] + l * DM, (l + 1 < DEPTH) ? (const float*)A.in[2] + (l + 1) * DM : nullptr, (bf16*)(Cp.ws + WS_XNB)); }
        if (l + 1 < DEPTH) SEAM(ph);
    }
#undef IN
#undef SEAM
}

#ifndef MK_MULTI
#define MK_MULTI 0
#endif
extern "C" void kernel_launch(void* const* d_in, const int* in_sizes, int n_in, void* d_out, int out_size, void* d_ws, size_t ws_size, hipStream_t stream) {
    static int grid = 0;
    if (grid == 0) {
        if (n_in != 26 || out_size != M * DM || ws_size < WS_END) { fprintf(stderr, "kernel_launch: unexpected problem (n_in %d, out %d, ws %zu)\n", n_in, out_size, ws_size); grid = -1; return; }
        int dev = 0, cus = 0, per_cu = 0;
        hipGetDevice(&dev); hipDeviceGetAttribute(&cus, hipDeviceAttributeMultiprocessorCount, dev);
        if (hipFuncSetAttribute((const void*)hybrid_fwd, hipFuncAttributeMaxDynamicSharedMemorySize, LDS_BYTES) != hipSuccess) { fprintf(stderr, "kernel_launch: hipFuncSetAttribute failed\n"); grid = -1; return; }
        if (hipOccupancyMaxActiveBlocksPerMultiprocessor(&per_cu, (const void*)hybrid_fwd, NTHR, LDS_BYTES) != hipSuccess || per_cu < 1) { fprintf(stderr, "kernel_launch: occupancy query says %d\n", per_cu); per_cu = 1; }
        (void)hipGetLastError();
        grid = cus * per_cu;
        fprintf(stderr, "kernel_launch: grid %d (cus %d x %d)\n", grid, cus, per_cu);
    }
    if (grid < 0) return;
    if (hipMemsetAsync((char*)d_ws + WS_BAR, 0, BAR_ZERO_BYTES, stream) != hipSuccess) { fprintf(stderr, "kernel_launch: hipMemsetAsync failed\n"); return; }
    Args a{};
    for (int i = 0; i < 26; ++i) a.in[i] = d_in[i];
    a.out = (float*)d_out; a.ws = (unsigned char*)d_ws;
#if MK_MULTI
    for (int p = 0; p < N_PHASES; ++p) { a.ph_lo = p; a.ph_hi = p + 1; hipLaunchKernelGGL(hybrid_fwd, dim3(grid), dim3(NTHR), LDS_BYTES, stream, a); }
#else
    a.ph_lo = 0; a.ph_hi = N_PHASES;
    void* kargs[] = {&a};
    hipError_t e = hipLaunchCooperativeKernel((const void*)hybrid_fwd, dim3(grid), dim3(NTHR), kargs, LDS_BYTES, stream);
    if (e != hipSuccess) fprintf(stderr, "kernel_launch: cooperative launch failed: %s (grid %d)\n", hipGetErrorString(e), grid);
#endif
}
```
